# Optimizing an MI355X kernel written in HIP

```python
import math
import jax, jax.numpy as jnp
from jax import lax
import numpy as np

D_MODEL = 1024
BATCH = 8
SEQ = 4096
DEPTH = 1

A_HEADS = 8
A_HEAD_DIM = 64
A_WIDTH = A_HEADS * A_HEAD_DIM
DECAY_LORA = 64
ICLR_LORA = 64
DECAY_SCALE = 0.6065306597
GN_EPS = 64e-5
B_HEADS = 8
QK_NOPE_DIM = 64
QK_ROPE_DIM = 32
V_HEAD_DIM = 64
Q_LORA_RANK = 256
KV_LORA_RANK = 128
B_WIDTH = B_HEADS * V_HEAD_DIM
ROPE_THETA = 10000.0
Q_BLOCK = 128
NORM_EPS = 1e-6
N_BRANCHES = 2
SHIFT_COLS = 3 * A_WIDTH + DECAY_LORA + ICLR_LORA
IN_COLS = SHIFT_COLS + A_WIDTH + Q_LORA_RANK + KV_LORA_RANK + QK_ROPE_DIM + B_WIDTH + N_BRANCHES * D_MODEL

kernel_name = 'hybrid_rwkv7_mla_gated_block'


def rmsnorm(x, g, eps=NORM_EPS):
    xf = x.astype(jnp.float32)
    y = xf * lax.rsqrt(jnp.mean(xf * xf, axis=-1, keepdims=True) + eps)
    return (y * g.astype(jnp.float32)).astype(x.dtype)


def split_cols(t, sizes):
    idx = np.cumsum(sizes)[:-1].tolist()
    return jnp.split(t, idx, axis=-1)


def token_shift(feat, mu):
    prev = jnp.pad(feat, ((0, 0), (1, 0), (0, 0)))[:, :-1, :]
    return feat + mu * (prev - feat)


def rwkv7_branch(feat, z, mu_shift, w0, w_decay_up, a0, w_iclr_up, k_k, k_a, r_k, gn_gain, gn_bias, w_out_a):
    bsz, seq, _ = feat.shape
    dt = feat.dtype
    f = token_shift(feat, mu_shift)
    r, k, v, wd, ad = split_cols(f, [A_WIDTH, A_WIDTH, A_WIDTH, DECAY_LORA, ICLR_LORA])
    w_logit = (w0 + jnp.tanh(wd) @ w_decay_up).astype(jnp.float32)
    w = jnp.exp(-DECAY_SCALE * jax.nn.sigmoid(w_logit))
    a = jax.nn.sigmoid((a0 + ad @ w_iclr_up).astype(jnp.float32))
    hs = lambda t: t.reshape(bsz, seq, A_HEADS, A_HEAD_DIM).astype(jnp.float32)
    r, k, v, w, a = hs(r), hs(k), hs(v), hs(w), hs(a)
    kk = k * k_k.reshape(A_HEADS, A_HEAD_DIM)
    kk = kk / jnp.maximum(jnp.linalg.norm(kk, axis=-1, keepdims=True), 1e-12)
    k = k * (1.0 + (a - 1.0) * k_a.reshape(A_HEADS, A_HEAD_DIM))

    def step(S, inp):
        r_t, w_t, k_t, v_t, kk_t, a_t = inp
        sa = jnp.einsum('bhvk,bhk->bhv', S, -kk_t)
        S = S * w_t[:, :, None, :] + sa[..., None] * (kk_t * a_t)[:, :, None, :] + v_t[..., None] * k_t[:, :, None, :]
        return S, jnp.einsum('bhvk,bhk->bhv', S, r_t)

    tm = lambda t: jnp.moveaxis(t, 1, 0)
    S0 = jnp.zeros((bsz, A_HEADS, A_HEAD_DIM, A_HEAD_DIM), jnp.float32)
    _, y = lax.scan(step, S0, (tm(r), tm(w), tm(k), tm(v), tm(kk), tm(a)))
    y = jnp.moveaxis(y, 0, 1)
    mean = jnp.mean(y, axis=-1, keepdims=True)
    var = jnp.mean(jnp.square(y - mean), axis=-1, keepdims=True)
    y = (y - mean) * lax.rsqrt(var + GN_EPS)
    y = y * gn_gain.reshape(A_HEADS, A_HEAD_DIM) + gn_bias.reshape(A_HEADS, A_HEAD_DIM)
    y = y + jnp.sum(r * k * r_k, axis=-1, keepdims=True) * v
    y = y.reshape(bsz, seq, A_WIDTH).astype(dt) * jax.nn.silu(z)
    return y @ w_out_a


def rope(t, cos, sin):
    t1, t2 = jnp.split(t, 2, axis=-1)
    return jnp.concatenate([t1 * cos - t2 * sin, t2 * cos + t1 * sin], axis=-1)


def mla_branch(c_q, c_kv, k_pe, z, positions, g_q, w_uq, g_kv, w_ukv, w_out_b):
    bsz, seq, _ = c_q.shape
    dt = c_q.dtype
    q = (rmsnorm(c_q, g_q) @ w_uq).reshape(bsz, seq, B_HEADS, QK_NOPE_DIM + QK_ROPE_DIM)
    q_nope, q_pe = q[..., :QK_NOPE_DIM], q[..., QK_NOPE_DIM:]
    kv = (rmsnorm(c_kv, g_kv) @ w_ukv).reshape(bsz, seq, B_HEADS, QK_NOPE_DIM + V_HEAD_DIM)
    k_nope, v = kv[..., :QK_NOPE_DIM], kv[..., QK_NOPE_DIM:]
    inv_freq = ROPE_THETA ** (-jnp.arange(0, QK_ROPE_DIM, 2, dtype=jnp.float32) / QK_ROPE_DIM)
    ang = positions.astype(jnp.float32)[..., None] * inv_freq
    cos, sin = jnp.cos(ang).astype(dt), jnp.sin(ang).astype(dt)
    q_pe = rope(q_pe, cos[:, :, None, :], sin[:, :, None, :])
    k_pe = rope(k_pe, cos, sin)
    scale = 1.0 / math.sqrt(QK_NOPE_DIM + QK_ROPE_DIM)
    nb = seq // Q_BLOCK
    blk = lambda t: jnp.moveaxis(t.reshape(bsz, nb, Q_BLOCK, *t.shape[2:]), 1, 0)
    key_idx = jnp.arange(seq)

    def attend(args):
        qn, qp, b = args
        s = jnp.einsum('bqhd,bkhd->bhqk', qn, k_nope) + jnp.einsum('bqhr,bkr->bhqk', qp, k_pe)
        s = s.astype(jnp.float32) * scale
        q_idx = b * Q_BLOCK + jnp.arange(Q_BLOCK)
        s = jnp.where(key_idx[None, :] <= q_idx[:, None], s, jnp.finfo(jnp.float32).min)
        p = jax.nn.softmax(s, axis=-1).astype(dt)
        return jnp.einsum('bhqk,bkhd->bqhd', p, v)

    o = lax.map(attend, (blk(q_nope), blk(q_pe), jnp.arange(nb)))
    o = jnp.moveaxis(o, 0, 1).reshape(bsz, seq, B_WIDTH)
    return (o * jax.nn.silu(z)) @ w_out_b


def setup_inputs(seed: int = 0) -> dict:
    key = jax.random.key(seed)
    ks = jax.random.split(key, 24)
    n = lambda i, shape, s=1.0: s * jax.random.normal(ks[i], shape, jnp.float32)
    x = n(0, (BATCH, SEQ, D_MODEL))
    positions = (jnp.arange(SEQ, dtype=jnp.int32)[None, :]
                 + jax.random.randint(ks[1], (BATCH, 1), 0, 1024, dtype=jnp.int32))
    return {
        'x': x,
        'positions': positions,
        'g_pre': 1.0 + n(2, (D_MODEL,), 0.05),
        'w_in': n(3, (D_MODEL, IN_COLS), D_MODEL ** -0.5),
        'b_gate': n(4, (N_BRANCHES * D_MODEL,), 0.01),
        'mu_shift': jax.random.uniform(ks[5], (SHIFT_COLS,), jnp.float32),
        'w0': n(6, (A_WIDTH,), 0.5),
        'w_decay_up': n(7, (DECAY_LORA, A_WIDTH), 0.1),
        'a0': n(8, (A_WIDTH,), 0.5),
        'w_iclr_up': n(9, (ICLR_LORA, A_WIDTH), 0.5 * ICLR_LORA ** -0.5),
        'k_k': 0.85 + n(10, (A_WIDTH,), 0.05),
        'k_a': 1.0 + n(11, (A_WIDTH,), 0.05),
        'r_k': n(12, (A_HEADS, A_HEAD_DIM), 0.1),
        'gn_gain': 1.0 + n(13, (A_WIDTH,), 0.05),
        'gn_bias': n(14, (A_WIDTH,), 0.01),
        'w_out_a': n(15, (A_WIDTH, D_MODEL), A_WIDTH ** -0.5),
        'g_q': 1.0 + n(16, (Q_LORA_RANK,), 0.05),
        'w_uq': n(17, (Q_LORA_RANK, B_HEADS * (QK_NOPE_DIM + QK_ROPE_DIM)), Q_LORA_RANK ** -0.5),
        'g_kv': 1.0 + n(18, (KV_LORA_RANK,), 0.05),
        'w_ukv': n(19, (KV_LORA_RANK, B_HEADS * (QK_NOPE_DIM + V_HEAD_DIM)), KV_LORA_RANK ** -0.5),
        'w_out_b': n(20, (B_WIDTH, D_MODEL), B_WIDTH ** -0.5),
        'w_o': n(21, (D_MODEL, D_MODEL), D_MODEL ** -0.5),
        'g_post': 1.0 + n(22, (D_MODEL,), 0.05),
    }


def reference(x, positions, g_pre, w_in, b_gate, mu_shift, w0, w_decay_up, a0, w_iclr_up, k_k, k_a, r_k,
              gn_gain, gn_bias, w_out_a, g_q, w_uq, g_kv, w_ukv, w_out_b, w_o, g_post):
    h = x
    for _ in range(DEPTH):
        u = rmsnorm(h, g_pre)
        proj = u @ w_in
        feat_a, z_a, c_q, c_kv, k_pe, z_b, gate_logits = split_cols(
            proj, [SHIFT_COLS, A_WIDTH, Q_LORA_RANK, KV_LORA_RANK, QK_ROPE_DIM, B_WIDTH, N_BRANCHES * D_MODEL])
        y_a = rwkv7_branch(feat_a, z_a, mu_shift, w0, w_decay_up, a0, w_iclr_up, k_k, k_a, r_k,
                           gn_gain, gn_bias, w_out_a)
        y_b = mla_branch(c_q, c_kv, k_pe, z_b, positions, g_q, w_uq, g_kv, w_ukv, w_out_b)
        gates = jax.nn.sigmoid(gate_logits + b_gate)
        g_a, g_b = gates[..., :D_MODEL], gates[..., D_MODEL:]
        merged = g_a * y_a + g_b * y_b
        h = h + rmsnorm(merged @ w_o, g_post)
    return h
```

```cpp
#include <hip/hip_runtime.h>
#include <hip/hip_cooperative_groups.h>
#include <cstdio>
namespace cg = cooperative_groups;

#ifndef PROBE
#define PROBE -1
#endif
#ifndef NAIVE_GEMM
#define NAIVE_GEMM 0
#endif
#ifndef NAIVE_ATTN
#define NAIVE_ATTN 0
#endif

typedef unsigned short u16;
typedef unsigned int u32;
typedef __attribute__((ext_vector_type(8))) short bf16x8;
typedef __attribute__((ext_vector_type(4))) short s16x4;
typedef __attribute__((ext_vector_type(16))) float f32x16;
#define DI __device__ __forceinline__

constexpr int T = 32768, SEQ = 4096, NB = 8, DM = 1024;
constexpr int INC = 5152, INP = 5248;
constexpr int FAW = 1664;
constexpr int C_ZA = 1664, C_CQ = 2176, C_ZB = 2592, C_G = 3104;
constexpr int LDU = 1088, LDY = 576, LDG = 2112, LDV = 4160, LDQW = 320;
constexpr int CQW = 416;
constexpr float DECAY_SCALE = 0.6065306597f;
constexpr float GN_EPS = 64e-5f;
constexpr float NORM_EPS = 1e-6f;

constexpr size_t O_WIN = 0;
constexpr size_t O_WUQ = O_WIN + (size_t)INP * LDU * 2;
constexpr size_t O_WUKV = O_WUQ + 768 * LDQW * 2;
constexpr size_t O_WOA = O_WUKV + 1024 * 128 * 2;
constexpr size_t O_WOB = O_WOA + 1024 * LDY * 2;
constexpr size_t O_WO = O_WOB + 1024 * LDY * 2;
constexpr size_t O_WDEC = O_WO + 1024 * LDU * 2;
constexpr size_t O_WICL = O_WDEC + 512 * 64 * 2;
constexpr size_t O_RSQ = O_WICL + 512 * 64 * 2;
constexpr size_t O_RSKV = O_RSQ + (size_t)T * 4;
constexpr size_t O_BONUS = O_RSKV + (size_t)T * 4;
constexpr size_t O_CS = O_BONUS + (size_t)T * 8 * 4;
constexpr size_t O_CNT = O_CS + (size_t)T * 32 * 4;
constexpr size_t O_U = O_CNT + 65536;
constexpr size_t O_FA = O_U + (size_t)T * LDU * 2;
constexpr size_t O_SZA = O_FA + (size_t)T * FAW * 2;
constexpr size_t O_SZB = O_SZA + (size_t)T * 512 * 2;
constexpr size_t O_CQKV = O_SZB + (size_t)T * 512 * 2;
constexpr size_t O_G = O_CQKV + (size_t)T * CQW * 2;
constexpr size_t O_Q = O_G + (size_t)T * LDG * 2;
constexpr size_t O_K = O_Q + (size_t)T * 768 * 2;
constexpr size_t WS_NEED = O_K + (size_t)T * 768 * 2;
static_assert(WS_NEED <= (size_t)536870912, "workspace budget");
constexpr size_t D_YA = 0;
constexpr size_t D_O = D_YA + (size_t)T * LDY * 2;
constexpr size_t D_VT = D_O + (size_t)T * LDY * 2;
constexpr size_t D_LA = D_VT + (size_t)64 * 64 * LDV * 2;
static_assert(D_LA + (size_t)T * 128 * 2 <= (size_t)T * 1024 * 4, "d_out scratch budget");

struct Params {
  const float* x; const int* pos; const float* g_pre; const float* w_in; const float* b_gate; const float* mu;
  const float* w0; const float* w_dec; const float* a0; const float* w_icl; const float* k_k; const float* k_a;
  const float* r_k; const float* gn_g; const float* gn_b; const float* w_oa; const float* g_q; const float* w_uq;
  const float* g_kv; const float* w_ukv; const float* w_ob; const float* w_o; const float* g_post;
  float* out; char* ws; long never;
};

DI u16 f2bf(float x) { u32 u = __float_as_uint(x); u += 0x7fffu + ((u >> 16) & 1u); return (u16)(u >> 16); }
DI float bf2f(u16 b) { return __uint_as_float(((u32)b) << 16); }
typedef __attribute__((ext_vector_type(2))) float f32x2;
typedef __attribute__((ext_vector_type(2))) __bf16 bf16x2_t;
DI u32 pack2(float a, float b) { f32x2 v = {a, b}; bf16x2_t q = __builtin_convertvector(v, bf16x2_t); return __builtin_bit_cast(u32, q); }
DI void st4(u16* p, float4 v) { uint2 o; o.x = pack2(v.x, v.y); o.y = pack2(v.z, v.w); *(uint2*)p = o; }
DI float4 ld4(const u16* p) { const uint2 u = *(const uint2*)p; return make_float4(__uint_as_float(u.x << 16), __uint_as_float(u.x & 0xffff0000u), __uint_as_float(u.y << 16), __uint_as_float(u.y & 0xffff0000u)); }
DI float sigmoidf_(float x) { return __builtin_amdgcn_rcpf(1.f + __expf(-x)); }
DI float siluf_(float x) { return x * __builtin_amdgcn_rcpf(1.f + __expf(-x)); }
DI float wave_sum(float v) {
#pragma unroll
  for (int o = 32; o > 0; o >>= 1) v += __shfl_xor(v, o, 64);
  return v;
}
template <int CTRL> DI float dpp_mov(float x) {
  return __builtin_bit_cast(float, __builtin_amdgcn_update_dpp(0, __builtin_bit_cast(int, x), CTRL, 0xf, 0xf, true));
}
DI float row16_sum(float x) {
  x += dpp_mov<0xB1>(x);
  x += dpp_mov<0x4E>(x);
  x += dpp_mov<0x141>(x);
  x += dpp_mov<0x140>(x);
  return x;
}


DI unsigned xcc_id() { return (unsigned)__builtin_amdgcn_s_getreg((3 << 11) | 20) & 0x7u; }
DI unsigned cu_key() { return ((unsigned)__builtin_amdgcn_s_getreg(63492) >> 8) & 0xffu; }
struct QState { int q, tried; };
DI int fetch_item(int* cnt, int per_q, QState& st) {
  __shared__ int s_q, s_tr, s_it;
  __syncthreads();
  if (threadIdx.x == 0) {
    int qq = st.q, tr = st.tried, it = -1;
    while (tr < 8) {
      it = atomicAdd(&cnt[qq], 1);
      if (it < per_q) break;
      it = -1; qq = (qq + 1) & 7; tr++;
    }
    s_q = qq; s_tr = tr; s_it = it;
  }
  __syncthreads();
  st.q = s_q; st.tried = s_tr;
  return s_it;
}


#define XB_XCNT(j) (64 * (j))
#define XB_XSUB(j) (512 + 64 * (j))
#define XB_XGEN(j) (1024 + 64 * (j))
#define XB_TOP 1536
#define XB_TOPGEN 1600
DI unsigned xb_ld(unsigned* p) { return __hip_atomic_load(p, __ATOMIC_RELAXED, __HIP_MEMORY_SCOPE_AGENT); }
DI unsigned xb_add(unsigned* p, unsigned v) { return __hip_atomic_fetch_add(p, v, __ATOMIC_RELAXED, __HIP_MEMORY_SCOPE_AGENT); }
struct GBar { unsigned* bar; unsigned x, nloc, nx; };
DI void gbar_init(GBar& g, unsigned* bar) {
  g.bar = bar; g.x = xcc_id(); g.nloc = 0; g.nx = 0;
  if (threadIdx.x == 0) (void)xb_add(&bar[XB_XCNT(g.x)], 1u);
}
DI void gbar_sync(GBar& g) {
  asm volatile("s_waitcnt vmcnt(0)" ::: "memory");
  __syncthreads();
  if (threadIdx.x == 0) {
    unsigned* bar = g.bar;
    if (g.nloc == 0u) {
      unsigned sum, cnt, mine;
      for (;;) {
        sum = 0u; cnt = 0u; mine = 0u;
#pragma unroll
        for (unsigned j = 0; j < 8; ++j) { const unsigned c = xb_ld(&bar[XB_XCNT(j)]); sum += c; cnt += (c > 0u) ? 1u : 0u; mine = (j == g.x) ? c : mine; }
        if (sum == gridDim.x) break;
        __builtin_amdgcn_s_sleep(1);
      }
      g.nloc = mine; g.nx = cnt;
    }
    const unsigned old = xb_add(&bar[XB_XSUB(g.x)], 1u);
    const unsigned gen = old / g.nloc;
    if (old + 1u == (gen + 1u) * g.nloc) {
      __builtin_amdgcn_fence(__ATOMIC_RELEASE, "agent");
      asm volatile("s_waitcnt vmcnt(0)" ::: "memory");
      const unsigned og = xb_add(&bar[XB_TOP], 1u);
      const unsigned tg = og / g.nx;
      if (og + 1u == (tg + 1u) * g.nx) xb_add(&bar[XB_TOPGEN], 1u);
      else while (xb_ld(&bar[XB_TOPGEN]) == tg) __builtin_amdgcn_s_sleep(1);
      __builtin_amdgcn_fence(__ATOMIC_ACQUIRE, "agent");
      xb_add(&bar[XB_XGEN(g.x)], 1u);
      asm volatile("s_waitcnt vmcnt(0)" ::: "memory");
    } else {
      while (xb_ld(&bar[XB_XGEN(g.x)]) == gen) __builtin_amdgcn_s_sleep(1);
      __builtin_amdgcn_fence(__ATOMIC_ACQUIRE, "agent");
      asm volatile("s_waitcnt vmcnt(0)" ::: "memory");
    }
  }
  __syncthreads();
}

struct SmemGemm { u16 a[2][128][72]; u16 b[2][128][72]; };
struct SmemAttn { u16 k[2][64][104]; u16 vt[2][64][72]; };
struct SmemScan { float vec[2][16][5][64]; float v[2][16][16]; float yp[16][16][16]; };
union __attribute__((aligned(16))) Smem { SmemGemm g; SmemAttn at; SmemScan sc; };

typedef __attribute__((ext_vector_type(4))) unsigned int u32x4;
#define G_LOAD(R, k0) do { \
    R##a0 = *(const u32x4*)(Ap + (k0)); R##a1 = *(const u32x4*)(Ap + sa32 + (k0)); R##a2 = *(const u32x4*)(Ap + 2 * sa32 + (k0)); R##a3 = *(const u32x4*)(Ap + 3 * sa32 + (k0)); \
    R##b0 = *(const u32x4*)(Bp + (k0)); R##b1 = *(const u32x4*)(Bp + sb32 + (k0)); R##b2 = *(const u32x4*)(Bp + 2 * sb32 + (k0)); R##b3 = *(const u32x4*)(Bp + 3 * sb32 + (k0)); } while (0)
#define G_STORE(buf, R) do { \
    *(u32x4*)&sm.a[buf][lrow][lkc] = R##a0; *(u32x4*)&sm.a[buf][lrow + 32][lkc] = R##a1; *(u32x4*)&sm.a[buf][lrow + 64][lkc] = R##a2; *(u32x4*)&sm.a[buf][lrow + 96][lkc] = R##a3; \
    *(u32x4*)&sm.b[buf][lrow][lkc] = R##b0; *(u32x4*)&sm.b[buf][lrow + 32][lkc] = R##b1; *(u32x4*)&sm.b[buf][lrow + 64][lkc] = R##b2; *(u32x4*)&sm.b[buf][lrow + 96][lkc] = R##b3; } while (0)
#define G_COMPUTE_LOW(buf) do {     \
    _Pragma("unroll") for (int s = 0; s < 4; s++) { \
      bf16x8 af[2], bfr[2]; \
      _Pragma("unroll") for (int i = 0; i < 2; i++) af[i] = *(const bf16x8*)&sm.a[buf][wm * 64 + i * 32 + r][s * 16 + h * 8]; \
      _Pragma("unroll") for (int j = 0; j < 2; j++) bfr[j] = *(const bf16x8*)&sm.b[buf][wn * 64 + j * 32 + r][s * 16 + h * 8]; \
      _Pragma("unroll") for (int i = 0; i < 2; i++) \
        _Pragma("unroll") for (int j = 0; j < 2; j++) acc[i][j] = __builtin_amdgcn_mfma_f32_32x32x16_bf16(af[i], bfr[j], acc[i][j], 0, 0, 0); \
    } } while (0)
#define G_COMPUTE(buf) do { \
    if (VAR == 1) { G_COMPUTE_LOW(buf); break; } \
    _Pragma("unroll") for (int hs = 0; hs < 2; hs++) {     \
      bf16x8 af[2][2], bfr[2][2]; \
      _Pragma("unroll") for (int s = 0; s < 2; s++) { \
        _Pragma("unroll") for (int i = 0; i < 2; i++) af[s][i] = *(const bf16x8*)&sm.a[buf][wm * 64 + i * 32 + r][(hs * 2 + s) * 16 + h * 8]; \
        _Pragma("unroll") for (int j = 0; j < 2; j++) bfr[s][j] = *(const bf16x8*)&sm.b[buf][wn * 64 + j * 32 + r][(hs * 2 + s) * 16 + h * 8]; \
      } \
      __builtin_amdgcn_sched_barrier(0); \
      _Pragma("unroll") for (int s = 0; s < 2; s++) \
        _Pragma("unroll") for (int i = 0; i < 2; i++) \
          _Pragma("unroll") for (int j = 0; j < 2; j++) acc[i][j] = __builtin_amdgcn_mfma_f32_32x32x16_bf16(af[s][i], bfr[s][j], acc[i][j], 0, 0, 0); \
      __builtin_amdgcn_sched_barrier(0); \
    } \
  } while (0)
#define G_STEP(kt, bufc, bufn) do { \
    const int kl_ = ((kt) + 2 < nk) ? (kt) + 2 : nk - 1;     \
    G_COMPUTE(bufc); \
    G_STORE(bufn, R0); \
    G_LOAD(R0, kl_ << 6); \
    __syncthreads(); } while (0)

template <int VAR = 0> DI void gemm_tile_acc(const u16* __restrict__ A, int lda, const u16* __restrict__ Bt, int ldb, int K,
                      int m0, int n0, f32x16 (&acc)[2][2], SmemGemm& sm) {
  const int tid = threadIdx.x, lane = tid & 63, w = tid >> 6, wm = w >> 1, wn = w & 1, r = lane & 31, h = lane >> 5;
  const int lrow = tid >> 3, lkc = (tid & 7) * 8;
  const u16* Ap = A + (size_t)(m0 + lrow) * lda + lkc;
  const u16* Bp = Bt + (size_t)(n0 + lrow) * ldb + lkc;
  const size_t sa32 = (size_t)32 * lda, sb32 = (size_t)32 * ldb;
  const int nk = K >> 6;
  u32x4 R0a0, R0a1, R0a2, R0a3, R0b0, R0b1, R0b2, R0b3;
  G_LOAD(R0, 0);
  __syncthreads();
  G_STORE(0, R0);
  if (nk == 1) {
    __syncthreads();
    G_COMPUTE(0);
    __syncthreads();
    return;
  }
  G_LOAD(R0, 64);
  __syncthreads();
  __builtin_amdgcn_s_setprio(1);
#pragma unroll 1
  for (int kt = 0; kt < nk; kt += 2) {
    G_STEP(kt, 0, 1);
    G_STEP(kt + 1, 1, 0);
  }
  __builtin_amdgcn_s_setprio(0);
}

DI void gemm_tile_dual(const u16* __restrict__ A1, const u16* __restrict__ B1, const u16* __restrict__ A2, const u16* __restrict__ B2,
                       int lda, int ldb, int m0, int n0, f32x16 (&acc)[2][2], u32 (&pk1)[2][2][8], SmemGemm& sm) {
  constexpr int VAR = 1;
  const int tid = threadIdx.x, lane = tid & 63, w = tid >> 6, wm = w >> 1, wn = w & 1, r = lane & 31, h = lane >> 5;
  const int lrow = tid >> 3, lkc = (tid & 7) * 8;
  const u16* A1p = A1 + (size_t)(m0 + lrow) * lda + lkc;
  const u16* B1p = B1 + (size_t)(n0 + lrow) * ldb + lkc;
  const u16* A2p = A2 + (size_t)(m0 + lrow) * lda + lkc;
  const u16* B2p = B2 + (size_t)(n0 + lrow) * ldb + lkc;
  const size_t sa32 = (size_t)32 * lda, sb32 = (size_t)32 * ldb;
  constexpr int nk = 16;
  u32x4 R0a0, R0a1, R0a2, R0a3, R0b0, R0b1, R0b2, R0b3;
#define GD_LOAD(kl) do { const int kl_ = (kl) < nk ? (kl) : nk - 1; \
    const u16* Ap = (kl_ < 8) ? A1p : A2p; const u16* Bp = (kl_ < 8) ? B1p : B2p; G_LOAD(R0, (kl_ & 7) << 6); } while (0)
#define GD_STEP(kt, bufc, bufn) do { G_COMPUTE(bufc); G_STORE(bufn, R0); GD_LOAD((kt) + 2); __syncthreads(); } while (0)
  GD_LOAD(0);
  __syncthreads();
  G_STORE(0, R0);
  GD_LOAD(1);
  __syncthreads();
  __builtin_amdgcn_s_setprio(1);
#pragma unroll 1
  for (int kt = 0; kt < nk; kt += 2) {
    if (kt == 8) {
#pragma unroll
      for (int i = 0; i < 2; i++)
#pragma unroll
        for (int j = 0; j < 2; j++) {
#pragma unroll
          for (int q = 0; q < 8; q++) pk1[i][j][q] = pack2(acc[i][j][2 * q], acc[i][j][2 * q + 1]);
#pragma unroll
          for (int g = 0; g < 16; g++) acc[i][j][g] = 0.f;
        }
    }
    GD_STEP(kt, 0, 1);
    GD_STEP(kt + 1, 1, 0);
  }
  __builtin_amdgcn_s_setprio(0);
}

DI void acc_zero(f32x16 (&acc)[2][2]) {
#pragma unroll
  for (int i = 0; i < 2; i++)
#pragma unroll
    for (int j = 0; j < 2; j++)
#pragma unroll
      for (int g = 0; g < 16; g++) acc[i][j][g] = 0.f;
}

template <class F> DI void acc_epilogue(f32x16 (&acc)[2][2], int m0, int n0, SmemGemm& sm, F f) {
  const int lane = threadIdx.x & 63, w = threadIdx.x >> 6, wm = w >> 1, wn = w & 1, r = lane & 31, h = lane >> 5;
  float* wb = (float*)&sm + w * (64 * 68);
#pragma unroll
  for (int i = 0; i < 2; i++)
#pragma unroll
    for (int j = 0; j < 2; j++)
#pragma unroll
      for (int g = 0; g < 16; g++)
        wb[(i * 32 + (g & 3) + 8 * (g >> 2) + 4 * h) * 68 + j * 32 + r] = acc[i][j][g];
  __syncthreads();
  const int rl = lane >> 4, c4 = (lane & 15) * 4;
#pragma unroll 4
  for (int it = 0; it < 16; it++) {
    const int row_l = it * 4 + rl;
    const float4 v = *(const float4*)&wb[row_l * 68 + c4];
    f(m0 + wm * 64 + row_l, n0 + wn * 64 + c4, v);
  }
}

template <class F> DI void acc_epilogue2(const u32 (&pk1)[2][2][8], f32x16 (&acc2)[2][2], int m0, int n0, SmemGemm& sm, F f) {
  const int lane = threadIdx.x & 63, w = threadIdx.x >> 6, wm = w >> 1, wn = w & 1, r = lane & 31, h = lane >> 5;
  float* wb = (float*)&sm + w * (64 * 68);
  const int rl = lane >> 4, c4 = (lane & 15) * 4;
  int lz;
  asm volatile("v_mov_b32 %0, 0" : "=v"(lz));
  m0 += lz;
  uint2 v1[16];
#pragma unroll
  for (int i = 0; i < 2; i++)
#pragma unroll
    for (int j = 0; j < 2; j++)
#pragma unroll
      for (int q = 0; q < 8; q++) {
        const int g0 = 2 * q, g1 = 2 * q + 1;
        wb[(i * 32 + (g0 & 3) + 8 * (g0 >> 2) + 4 * h) * 68 + j * 32 + r] = __uint_as_float(pk1[i][j][q] << 16);
        wb[(i * 32 + (g1 & 3) + 8 * (g1 >> 2) + 4 * h) * 68 + j * 32 + r] = __uint_as_float(pk1[i][j][q] & 0xffff0000u);
      }
  __syncthreads();
#pragma unroll
  for (int it = 0; it < 16; it++) {
    const float4 t = *(const float4*)&wb[(it * 4 + rl) * 68 + c4];
    v1[it] = make_uint2(pack2(t.x, t.y), pack2(t.z, t.w));
  }
  __syncthreads();
#pragma unroll
  for (int i = 0; i < 2; i++)
#pragma unroll
    for (int j = 0; j < 2; j++)
#pragma unroll
      for (int g = 0; g < 16; g++)
        wb[(i * 32 + (g & 3) + 8 * (g >> 2) + 4 * h) * 68 + j * 32 + r] = acc2[i][j][g];
  __syncthreads();
#pragma unroll
  for (int it = 0; it < 16; it++) {
    const int row_l = it * 4 + rl;
    const float4 v2 = *(const float4*)&wb[row_l * 68 + c4];
    const float4 va = make_float4(__uint_as_float(v1[it].x << 16), __uint_as_float(v1[it].x & 0xffff0000u),
                                  __uint_as_float(v1[it].y << 16), __uint_as_float(v1[it].y & 0xffff0000u));
    f(m0 + wm * 64 + row_l, n0 + wn * 64 + c4, va, v2);
  }
}

DI float4 silu4(float4 v) { return make_float4(siluf_(v.x), siluf_(v.y), siluf_(v.z), siluf_(v.w)); }
DI float4 sigm4(float4 v) { return make_float4(sigmoidf_(v.x), sigmoidf_(v.y), sigmoidf_(v.z), sigmoidf_(v.w)); }

DI void transpose_cvt(const float* __restrict__ src, int K, int N, u16* __restrict__ dst, int ldd, const float* __restrict__ kscale,
                      long gtid, long nth) {
  const long tot = (long)(K >> 3) * N;
  for (long idx = gtid; idx < tot; idx += nth) {
    const int kb = (int)(idx / N), n = (int)(idx - (long)kb * N), k0 = kb * 8;
    float v[8];
#pragma unroll
    for (int j = 0; j < 8; j++) v[j] = src[(size_t)(k0 + j) * N + n];
    if (kscale) {
#pragma unroll
      for (int j = 0; j < 8; j++) v[j] *= kscale[k0 + j];
    }
    uint4 o;
    o.x = pack2(v[0], v[1]); o.y = pack2(v[2], v[3]); o.z = pack2(v[4], v[5]); o.w = pack2(v[6], v[7]);
    *(uint4*)(dst + (size_t)n * ldd + k0) = o;
  }
}

DI void phase0(const Params& p) {
  const long gtid = (long)blockIdx.x * 256 + threadIdx.x, nth = (long)gridDim.x * 256;
  char* ws = p.ws;
  transpose_cvt(p.w_in, 1024, INC, (u16*)(ws + O_WIN), LDU, nullptr, gtid, nth);
  for (long idx = gtid; idx < (long)(INP - INC) * LDU; idx += nth) ((u16*)(ws + O_WIN))[(size_t)INC * LDU + idx] = 0;
  transpose_cvt(p.w_uq, 256, 768, (u16*)(ws + O_WUQ), LDQW, p.g_q, gtid, nth);
  transpose_cvt(p.w_ukv, 128, 1024, (u16*)(ws + O_WUKV), 128, p.g_kv, gtid, nth);
  transpose_cvt(p.w_oa, 512, 1024, (u16*)(ws + O_WOA), LDY, nullptr, gtid, nth);
  transpose_cvt(p.w_ob, 512, 1024, (u16*)(ws + O_WOB), LDY, nullptr, gtid, nth);
  transpose_cvt(p.w_o, 1024, 1024, (u16*)(ws + O_WO), LDU, nullptr, gtid, nth);
  transpose_cvt(p.w_dec, 64, 512, (u16*)(ws + O_WDEC), 64, nullptr, gtid, nth);
  transpose_cvt(p.w_icl, 64, 512, (u16*)(ws + O_WICL), 64, nullptr, gtid, nth);

  const int lane = threadIdx.x & 63;
  const long wave = gtid >> 6, nw = nth >> 6;
  u16* U = (u16*)(ws + O_U);
  for (long row = wave; row < T; row += nw) {
    const float4* xr = (const float4*)(p.x + row * 1024);
    float4 v[4];
    float ss = 0.f;
#pragma unroll
    for (int i = 0; i < 4; i++) { v[i] = xr[lane + 64 * i]; ss += v[i].x * v[i].x + v[i].y * v[i].y + v[i].z * v[i].z + v[i].w * v[i].w; }
    ss = wave_sum(ss);
    const float rs = rsqrtf(ss * (1.f / 1024.f) + NORM_EPS);
#pragma unroll
    for (int i = 0; i < 4; i++) {
      float4 g = ((const float4*)p.g_pre)[lane + 64 * i];
      uint2 o;
      o.x = pack2(v[i].x * rs * g.x, v[i].y * rs * g.y);
      o.y = pack2(v[i].z * rs * g.z, v[i].w * rs * g.w);
      *(uint2*)(U + row * LDU + (lane + 64 * i) * 4) = o;
    }
  }
}

DI void phase1(const Params& p, Smem& sm, int* cnt) {
  char* ws = p.ws;
  const u16* U = (const u16*)(ws + O_U);
  const u16* W = (const u16*)(ws + O_WIN);
  u16* FA = (u16*)(ws + O_FA); u16* SZA = (u16*)(ws + O_SZA); u16* SZB = (u16*)(ws + O_SZB);
  u16* CQKV = (u16*)(ws + O_CQKV); u16* G = (u16*)(ws + O_G);
  const float* bg = p.b_gate;
  const int xcd = blockIdx.x & 7, lb = blockIdx.x >> 3, nlb = gridDim.x >> 3;
  for (int li = lb; li < 32 * 41; li += nlb) {
    const int g = li / 328, rem = li - g * 328, nt = rem >> 3, mt = xcd * 32 + g * 8 + (rem & 7);
    f32x16 acc[2][2];
    acc_zero(acc);
    gemm_tile_acc(U, LDU, W, LDU, 1024, mt * 128, nt * 128, acc, sm.g);
    acc_epilogue(acc, mt * 128, nt * 128, sm.g, [&](int row, int col, float4 v) {
      if (col < C_ZA) st4(FA + (size_t)row * FAW + col, v);
      else if (col < C_CQ) st4(SZA + (size_t)row * 512 + (col - C_ZA), silu4(v));
      else if (col < C_ZB) st4(CQKV + (size_t)row * CQW + (col - C_CQ), v);
      else if (col < C_G) st4(SZB + (size_t)row * 512 + (col - C_ZB), silu4(v));
      else if (col < INC) {
        const float4 bb = *(const float4*)(bg + (col - C_G));
        st4(G + (size_t)row * LDG + (col - C_G), sigm4(make_float4(v.x + bb.x, v.y + bb.y, v.z + bb.z, v.w + bb.w)));
      }
    });
  }
}

DI void phase2(const Params& p) {
  const long gtid = (long)blockIdx.x * 256 + threadIdx.x, nth = (long)gridDim.x * 256;
  const int lane = threadIdx.x & 63, sub = lane >> 4, l16 = lane & 15;
  const long wave = gtid >> 6, nw = nth >> 6;
  char* ws = p.ws;
  const u16* FA = (const u16*)(ws + O_FA);
  const u16* CQKV = (const u16*)(ws + O_CQKV);
  u16* LA = (u16*)((char*)p.out + D_LA);
  u16* Kb = (u16*)(ws + O_K);
  float* RSQ = (float*)(ws + O_RSQ); float* RSKV = (float*)(ws + O_RSKV);
  float* CS = (float*)(ws + O_CS);
  const float4 mu_wd = *(const float4*)(p.mu + 1536 + l16 * 4), mu_ad = *(const float4*)(p.mu + 1600 + l16 * 4);
  const float inv_freq = powf(10000.0f, -(float)l16 / 16.0f);
  for (long it = wave; it < T / 4; it += nw) {
    const long t = it * 4 + sub;
    const int s = (int)(t & (SEQ - 1)), b = (int)(t >> 12);
    const u16* fa = FA + t * FAW;
    const u16* fp = (s > 0) ? fa - FAW : fa;
    {
      const float4 f = ld4(fa + 1536 + l16 * 4);
      float4 pv = ld4(fp + 1536 + l16 * 4);
      if (s == 0) pv = make_float4(0.f, 0.f, 0.f, 0.f);
      st4(LA + t * 128 + l16 * 4, make_float4(tanhf(f.x + mu_wd.x * (pv.x - f.x)), tanhf(f.y + mu_wd.y * (pv.y - f.y)),
                                              tanhf(f.z + mu_wd.z * (pv.z - f.z)), tanhf(f.w + mu_wd.w * (pv.w - f.w))));
      const float4 f2 = ld4(fa + 1600 + l16 * 4);
      float4 pv2 = ld4(fp + 1600 + l16 * 4);
      if (s == 0) pv2 = make_float4(0.f, 0.f, 0.f, 0.f);
      st4(LA + t * 128 + 64 + l16 * 4, make_float4(f2.x + mu_ad.x * (pv2.x - f2.x), f2.y + mu_ad.y * (pv2.y - f2.y),
                                                   f2.z + mu_ad.z * (pv2.z - f2.z), f2.w + mu_ad.w * (pv2.w - f2.w)));
    }
    const u16* c = CQKV + t * CQW;
    float ss = 0.f, ss2 = 0.f;
#pragma unroll
    for (int i = 0; i < 4; i++) { const float4 v = ld4(c + i * 64 + l16 * 4); ss += (v.x * v.x + v.y * v.y) + (v.z * v.z + v.w * v.w); }
#pragma unroll
    for (int i = 0; i < 2; i++) { const float4 v = ld4(c + 256 + i * 64 + l16 * 4); ss2 += (v.x * v.x + v.y * v.y) + (v.z * v.z + v.w * v.w); }
    ss = row16_sum(ss);
    ss2 = row16_sum(ss2);
    if (l16 == 0) {
      RSQ[t] = rsqrtf(ss * (1.f / 256.f) + NORM_EPS);
      RSKV[t] = rsqrtf(ss2 * (1.f / 128.f) + NORM_EPS);
    }
    {
      const float t1 = bf2f(c[384 + l16]), t2 = bf2f(c[400 + l16]);
      const float ang = (float)p.pos[t] * inv_freq;
      const float cs = cosf(ang), sn = sinf(ang);
      CS[t * 32 + l16] = cs;
      CS[t * 32 + 16 + l16] = sn;
      const u16 o1 = f2bf(t1 * cs - t2 * sn), o2 = f2bf(t2 * cs + t1 * sn);
#pragma unroll
      for (int hh = 0; hh < 8; hh++) {
        const size_t base = ((size_t)(b * 8 + hh) * SEQ + s) * 96 + 64;
        Kb[base + l16] = o1;
        Kb[base + 16 + l16] = o2;
      }
    }
  }
}

DI void kv_epilogue(f32x16 (&acc)[2][2], int m0, int hh, SmemGemm& sm, const float* __restrict__ RSKV, u16* __restrict__ Kb, u16* __restrict__ Vt) {
  const int lane = threadIdx.x & 63, w = threadIdx.x >> 6, wm = w >> 1, wn = w & 1, r = lane & 31, h = lane >> 5;
  float* wb = (float*)&sm + w * (64 * 68);
#pragma unroll
  for (int i = 0; i < 2; i++)
#pragma unroll
    for (int j = 0; j < 2; j++)
#pragma unroll
      for (int g = 0; g < 16; g++)
        wb[(i * 32 + (g & 3) + 8 * (g >> 2) + 4 * h) * 68 + j * 32 + r] = acc[i][j][g];
  __syncthreads();
  const int row0 = m0 + wm * 64, b = row0 >> 12, s0 = row0 & (SEQ - 1);
  if (wn == 0) {
    const int rl = lane >> 4, c4 = (lane & 15) * 4;
#pragma unroll 4
    for (int it = 0; it < 16; it++) {
      const int row_l = it * 4 + rl;
      float4 v = *(const float4*)&wb[row_l * 68 + c4];
      const float rs = RSKV[row0 + row_l];
      v.x *= rs; v.y *= rs; v.z *= rs; v.w *= rs;
      st4(Kb + ((size_t)(b * 8 + hh) * SEQ + s0 + row_l) * 96 + c4, v);
    }
  } else {
    u16* vp = Vt + ((size_t)(b * 8 + hh) * 64 + lane) * LDV + s0;
#pragma unroll 4
    for (int rg = 0; rg < 16; rg++) {
      const float4 rs = *(const float4*)(RSKV + row0 + rg * 4);
      float4 v;
      v.x = wb[(rg * 4 + 0) * 68 + lane] * rs.x; v.y = wb[(rg * 4 + 1) * 68 + lane] * rs.y;
      v.z = wb[(rg * 4 + 2) * 68 + lane] * rs.z; v.w = wb[(rg * 4 + 3) * 68 + lane] * rs.w;
      st4(vp + rg * 4, v);
    }
  }
}

DI void phase3(const Params& p, Smem& sm, int* cnt) {
  char* ws = p.ws;
  const u16* LA = (const u16*)((char*)p.out + D_LA);
  const u16* CQKV = (const u16*)(ws + O_CQKV);
  u16* NLW = (u16*)(ws + O_U);
  u16* Ab = (u16*)(ws + O_U + (size_t)T * 512 * 2);
  u16* Qb = (u16*)(ws + O_Q);
  u16* Kb = (u16*)(ws + O_K);
  u16* Vt = (u16*)((char*)p.out + D_VT);
  const float* RSQ = (const float*)(ws + O_RSQ);
  const float* RSKV = (const float*)(ws + O_RSKV);
  const float* CS = (const float*)(ws + O_CS);
  const float qscale = 1.4426950408889634f * 0.10206207261596575f;
  const int n_dec = 32 * 4, n_icl = 32 * 4, n_q = 32 * 6, n_kv = 32 * 8;
  const int xcd = blockIdx.x & 7, lb = blockIdx.x >> 3, nlb = gridDim.x >> 3;
  for (int li = lb; li < n_dec + n_icl + n_q + n_kv; li += nlb) {
    f32x16 acc[2][2];
    acc_zero(acc);
    if (li < n_dec) {
      const int mt = xcd * 32 + (li >> 2), nt = li & 3;
      gemm_tile_acc(LA, 128, (const u16*)(ws + O_WDEC), 64, 64, mt * 128, nt * 128, acc, sm.g);
      const float* w0 = p.w0;
      acc_epilogue(acc, mt * 128, nt * 128, sm.g, [&](int row, int col, float4 v) {
        const float4 ww = *(const float4*)(w0 + col);
        st4(NLW + (size_t)row * 512 + col, make_float4(1.f - __expf(-DECAY_SCALE * sigmoidf_(ww.x + v.x)), 1.f - __expf(-DECAY_SCALE * sigmoidf_(ww.y + v.y)),
                                                       1.f - __expf(-DECAY_SCALE * sigmoidf_(ww.z + v.z)), 1.f - __expf(-DECAY_SCALE * sigmoidf_(ww.w + v.w))));
      });
    } else if (li < n_dec + n_icl) {
      const int tt = li - n_dec, mt = xcd * 32 + (tt >> 2), nt = tt & 3;
      gemm_tile_acc(LA + 64, 128, (const u16*)(ws + O_WICL), 64, 64, mt * 128, nt * 128, acc, sm.g);
      const float* a0 = p.a0;
      acc_epilogue(acc, mt * 128, nt * 128, sm.g, [&](int row, int col, float4 v) {
        const float4 aa = *(const float4*)(a0 + col);
        st4(Ab + (size_t)row * 512 + col, sigm4(make_float4(aa.x + v.x, aa.y + v.y, aa.z + v.z, aa.w + v.w)));
      });
    } else if (li < n_dec + n_icl + n_q) {
      const int tt = li - n_dec - n_icl, ml = tt / 6, nt = tt - ml * 6, mt = xcd * 32 + ml;
      gemm_tile_acc(CQKV, CQW, (const u16*)(ws + O_WUQ), LDQW, 256, mt * 128, nt * 128, acc, sm.g);
      acc_epilogue(acc, mt * 128, nt * 128, sm.g, [&](int row, int col, float4 v) {
        const int hh = col / 96, d = col - hh * 96, b = row >> 12, s = row & (SEQ - 1);
        const float rs = RSQ[row] * qscale;
        v.x *= rs; v.y *= rs; v.z *= rs; v.w *= rs;
        float4 pv;
        {
          const bool up = (d < 80);
          const float ax = dpp_mov<0x104>(v.x), bx = dpp_mov<0x114>(v.x);
          const float ay = dpp_mov<0x104>(v.y), by = dpp_mov<0x114>(v.y);
          const float az = dpp_mov<0x104>(v.z), bz = dpp_mov<0x114>(v.z);
          const float aw = dpp_mov<0x104>(v.w), bw = dpp_mov<0x114>(v.w);
          pv.x = up ? ax : bx; pv.y = up ? ay : by; pv.z = up ? az : bz; pv.w = up ? aw : bw;
        }
        if (d >= 64) {
          const int i = (d - 64) & 15;
          const float4 cs = *(const float4*)(CS + (size_t)row * 32 + i);
          const float4 sn = *(const float4*)(CS + (size_t)row * 32 + 16 + i);
          const float sg = (d < 80) ? -1.f : 1.f;
          v.x = v.x * cs.x + sg * pv.x * sn.x; v.y = v.y * cs.y + sg * pv.y * sn.y;
          v.z = v.z * cs.z + sg * pv.z * sn.z; v.w = v.w * cs.w + sg * pv.w * sn.w;
        }
        st4(Qb + ((size_t)(b * 8 + hh) * SEQ + s) * 96 + d, v);
      });
    } else {
      const int tt = li - n_dec - n_icl - n_q, mt = xcd * 32 + (tt >> 3), nt = tt & 7;
      gemm_tile_acc(CQKV + 256, CQW, (const u16*)(ws + O_WUKV), 128, 128, mt * 128, nt * 128, acc, sm.g);
      kv_epilogue(acc, mt * 128, nt, sm.g, RSKV, Kb, Vt);
    }
  }
}

DI void scan_item(const Params& p, int item, SmemScan& sm) {
  const int tid = threadIdx.x, lane = tid & 63, w = tid >> 6;
  const int vg = item & 3, bh = item >> 2, hh = bh & 7, b = bh >> 3;
  char* ws = p.ws;
  const u16* FA = (const u16*)(ws + O_FA);
  const u16* NLW = (const u16*)(ws + O_U);
  const u16* Ab = (const u16*)(ws + O_U + (size_t)T * 512 * 2);
  float* BONUS = (float*)(ws + O_BONUS);
  u16* Y = (u16*)((char*)p.out + D_YA);
  const int st = tid >> 4, kq = tid & 15, col = hh * 64 + kq * 4;
  float mu_r[4], mu_k[4], ckk[4], cka[4], crk[4], omc[4];
  const int vch = hh * 64 + vg * 16 + kq;
  const float mu_v1 = p.mu[1024 + vch];
#pragma unroll
  for (int i = 0; i < 4; i++) {
    mu_r[i] = p.mu[col + i]; mu_k[i] = p.mu[512 + col + i];
    ckk[i] = p.k_k[col + i]; cka[i] = p.k_a[col + i]; crk[i] = p.r_k[col + i]; omc[i] = 1.f - cka[i];
  }
  struct SIn { uint2 rf, rp, kf, kp, a, w; unsigned vf, vp; };
  auto issue = [&](int tc, SIn& g) {
    const int s = tc + st;
    const size_t t = (size_t)b * SEQ + s;
    const u16* fa = FA + t * FAW + col;
    const u16* fp = (s > 0) ? fa - FAW : fa;
    g.rf = *(const uint2*)(fa);
    g.kf = *(const uint2*)(fa + 512);
    g.vf = fa[1024 + vch - col];
    g.rp = *(const uint2*)(fp);
    g.kp = *(const uint2*)(fp + 512);
    g.vp = fp[1024 + vch - col];
    g.a = *(const uint2*)(Ab + t * 512 + col);
    g.w = *(const uint2*)(NLW + t * 512 + col);
  };
  auto unp = [](uint2 u, float (&f)[4]) {
    f[0] = __uint_as_float(u.x << 16); f[1] = __uint_as_float(u.x & 0xffff0000u);
    f[2] = __uint_as_float(u.y << 16); f[3] = __uint_as_float(u.y & 0xffff0000u);
  };
  auto process = [&](int tc, const SIn& g, int pb) {
    float rf[4], rp[4], kf[4], kp[4], av[4], nl[4];
    unp(g.rf, rf); unp(g.rp, rp); unp(g.kf, kf); unp(g.kp, kp); unp(g.a, av); unp(g.w, nl);
    const float vf1 = __uint_as_float(g.vf << 16);
    float vp1 = __uint_as_float(g.vp << 16);
    if (tc + st == 0) {
#pragma unroll
      for (int i = 0; i < 4; i++) { rp[i] = 0.f; kp[i] = 0.f; }
      vp1 = 0.f;
    }
    float rr[4], ks[4], kkr[4];
    float n2 = 0.f, bon = 0.f;
#pragma unroll
    for (int i = 0; i < 4; i++) {
      rr[i] = rf[i] + mu_r[i] * (rp[i] - rf[i]);
      ks[i] = kf[i] + mu_k[i] * (kp[i] - kf[i]);
      kkr[i] = ks[i] * ckk[i];
      n2 += kkr[i] * kkr[i];
    }
    n2 = row16_sum(n2);
    const float inv = __builtin_amdgcn_rsqf(fmaxf(n2, 1e-24f));
    float4 o_w, o_kk, o_b, o_kx, o_r;
    float kx[4], kk[4];
#pragma unroll
    for (int i = 0; i < 4; i++) {
      kk[i] = kkr[i] * inv;
      kx[i] = ks[i] * (av[i] * cka[i] + omc[i]);
      bon += rr[i] * kx[i] * crk[i];
    }
    bon = row16_sum(bon);
    o_w = make_float4(1.f - nl[0], 1.f - nl[1], 1.f - nl[2], 1.f - nl[3]);
    o_kk = make_float4(kk[0], kk[1], kk[2], kk[3]);
    o_b = make_float4(kk[0] * av[0], kk[1] * av[1], kk[2] * av[2], kk[3] * av[3]);
    o_kx = make_float4(kx[0], kx[1], kx[2], kx[3]);
    o_r = make_float4(rr[0], rr[1], rr[2], rr[3]);
    *(float4*)&sm.vec[pb][st][0][kq * 4] = o_w;
    *(float4*)&sm.vec[pb][st][1][kq * 4] = o_kk;
    *(float4*)&sm.vec[pb][st][2][kq * 4] = o_b;
    *(float4*)&sm.vec[pb][st][3][kq * 4] = o_kx;
    *(float4*)&sm.vec[pb][st][4][kq * 4] = o_r;
    sm.v[pb][st][kq] = vf1 + mu_v1 * (vp1 - vf1);
    if (vg == 0 && kq == 0) BONUS[((size_t)b * SEQ + tc + st) * 8 + hh] = bon;
  };
  const int vl = lane >> 4, kg = lane & 15;
  const int rowb = w * 4 + vl;
  f32x2 S01 = {0.f, 0.f}, S23 = {0.f, 0.f};
  const int ys = lane >> 2, yr = w * 4 + (lane & 3);
  SIn gA, gB;
  issue(0, gA);
  issue(16, gB);
  __syncthreads();
  process(0, gA, 0);
  __syncthreads();
#define LO2(v) (f32x2{(v).x, (v).y})
#define HI2(v) (f32x2{(v).z, (v).w})
#define SCAN_CHUNK(tc_, gfree, gnext, cb) do { \
    process(((tc_) + 16 < SEQ) ? (tc_) + 16 : SEQ - 16, gnext, (cb) ^ 1); \
    issue(((tc_) + 32 < SEQ) ? (tc_) + 32 : SEQ - 16, gfree); \
    float4 w4 = *(const float4*)&sm.vec[cb][0][0][kg * 4]; \
    float4 kk4 = *(const float4*)&sm.vec[cb][0][1][kg * 4]; \
    float4 b4 = *(const float4*)&sm.vec[cb][0][2][kg * 4]; \
    float4 kx4 = *(const float4*)&sm.vec[cb][0][3][kg * 4]; \
    float4 r4 = *(const float4*)&sm.vec[cb][0][4][kg * 4]; \
    float vv = sm.v[cb][0][rowb]; \
    _Pragma("unroll") for (int s = 0; s < 16; s++) { \
      const int sn = (s < 15) ? s + 1 : 15; \
      const float4 nw4 = *(const float4*)&sm.vec[cb][sn][0][kg * 4]; \
      const float4 nkk4 = *(const float4*)&sm.vec[cb][sn][1][kg * 4]; \
      const float4 nb4 = *(const float4*)&sm.vec[cb][sn][2][kg * 4]; \
      const float4 nkx4 = *(const float4*)&sm.vec[cb][sn][3][kg * 4]; \
      const float4 nr4 = *(const float4*)&sm.vec[cb][sn][4][kg * 4]; \
      const float nvv = sm.v[cb][sn][rowb]; \
      const f32x2 d2 = S23 * HI2(kk4) + S01 * LO2(kk4); \
      const f32x2 vv2 = {vv, vv}; \
      const f32x2 t01 = vv2 * LO2(kx4) + S01 * LO2(w4); \
      const f32x2 t23 = vv2 * HI2(kx4) + S23 * HI2(w4); \
      const float d = row16_sum(d2.x + d2.y); \
      const f32x2 dd = {d, d}; \
      S01 = t01 - dd * LO2(b4); \
      S23 = t23 - dd * HI2(b4); \
      const f32x2 y2 = S23 * HI2(r4) + S01 * LO2(r4); \
      sm.yp[s][rowb][kg] = y2.x + y2.y; \
      w4 = nw4; kk4 = nkk4; b4 = nb4; kx4 = nkx4; r4 = nr4; vv = nvv; \
    } \
    {     \
      const float4 p0 = *(const float4*)&sm.yp[ys][yr][0], p1 = *(const float4*)&sm.yp[ys][yr][4]; \
      const float4 p2 = *(const float4*)&sm.yp[ys][yr][8], p3 = *(const float4*)&sm.yp[ys][yr][12]; \
      const float y = ((p0.x + p0.y) + (p0.z + p0.w)) + ((p1.x + p1.y) + (p1.z + p1.w)) + ((p2.x + p2.y) + (p2.z + p2.w)) + ((p3.x + p3.y) + (p3.z + p3.w)); \
      Y[((size_t)b * SEQ + (tc_) + ys) * LDY + hh * 64 + vg * 16 + yr] = f2bf(y); \
    } \
    __syncthreads(); } while (0)
#pragma unroll 1
  for (int tc = 0; tc < SEQ; tc += 32) {
    SCAN_CHUNK(tc, gA, gB, 0);
    SCAN_CHUNK(tc + 16, gB, gA, 1);
  }
  __syncthreads();
}

DI void attn_item(const Params& p, int bh, int qb, SmemAttn& sm) {
  const int tid = threadIdx.x, lane = tid & 63, w = tid >> 6, r = lane & 31, h = lane >> 5;
  char* ws = p.ws;
  const u16* Qb = (const u16*)(ws + O_Q) + (size_t)bh * SEQ * 96;
  const u16* Kb = (const u16*)(ws + O_K) + (size_t)bh * SEQ * 96;
  const u16* Vt = (const u16*)((char*)p.out + D_VT) + (size_t)bh * 64 * LDV;
  const u16* SZB = (const u16*)(ws + O_SZB);
  u16* O = (u16*)((char*)p.out + D_O);
  const int b = bh >> 3, hh = bh & 7;
  const int q0 = qb * 128;
  const int qw = q0 + w * 32;
  const int qg = qw + r;
#if NAIVE_ATTN
  if (h == 0) {
    float m = -1e30f, l = 0.f;
    const size_t t = (size_t)b * SEQ + qg;
    for (int dc = 0; dc < 64; dc += 16) {
      float o[16];
      m = -1e30f; l = 0.f;
#pragma unroll
      for (int d = 0; d < 16; d++) o[d] = 0.f;
      for (int key = 0; key <= qg; key++) {
        float s = 0.f;
        for (int d = 0; d < 96; d++) s += bf2f(Qb[(size_t)qg * 96 + d]) * bf2f(Kb[(size_t)key * 96 + d]);
        float mn = fmaxf(m, s);
        float al = exp2f(m - mn), pp = exp2f(s - mn);
        l = l * al + pp;
#pragma unroll
        for (int d = 0; d < 16; d++) o[d] = o[d] * al + pp * bf2f(Vt[(size_t)(dc + d) * LDV + key]);
        m = mn;
      }
#pragma unroll
      for (int d = 0; d < 16; d++) O[t * LDY + hh * 64 + dc + d] = f2bf(o[d] / l * bf2f(SZB[t * 512 + hh * 64 + dc + d]));
    }
  }
#else
  bf16x8 bq[6];
#pragma unroll
  for (int s = 0; s < 6; s++) bq[s] = *(const bf16x8*)(Qb + (size_t)qg * 96 + s * 16 + h * 8);
  const f32x16 zero16 = {0.f, 0.f, 0.f, 0.f, 0.f, 0.f, 0.f, 0.f, 0.f, 0.f, 0.f, 0.f, 0.f, 0.f, 0.f, 0.f};
  f32x16 oacc[2];
#pragma unroll
  for (int g = 0; g < 16; g++) { oacc[0][g] = 0.f; oacc[1][g] = 0.f; }
  float m_run = -1e30f, l_run = 0.f;
  const int nkt = (q0 + 128) >> 6;
  u32x4 RK0, RK1, RK2, RV0, RV1;
  const int kr0 = tid / 12, kc0 = tid - kr0 * 12;
  const int kr1 = (tid + 256) / 12, kc1 = (tid + 256) - kr1 * 12;
  const int kr2 = (tid + 512) / 12, kc2 = (tid + 512) - kr2 * 12;
  const int vr0 = tid >> 3, vc0 = tid & 7;
#define ATT_KISSUE(kt_) do { const int k0_ = (((kt_) < nkt) ? (kt_) : nkt - 1) << 6; \
    RK0 = *(const u32x4*)(Kb + (size_t)(k0_ + kr0) * 96 + kc0 * 8); \
    RK1 = *(const u32x4*)(Kb + (size_t)(k0_ + kr1) * 96 + kc1 * 8); \
    RK2 = *(const u32x4*)(Kb + (size_t)(k0_ + kr2) * 96 + kc2 * 8); } while (0)
#define ATT_VISSUE(kt_) do { const int k0_ = (((kt_) < nkt) ? (kt_) : nkt - 1) << 6; \
    RV0 = *(const u32x4*)(Vt + (size_t)vr0 * LDV + k0_ + vc0 * 8); \
    RV1 = *(const u32x4*)(Vt + (size_t)(vr0 + 32) * LDV + k0_ + vc0 * 8); } while (0)
#define ATT_KSTASH(buf) do { \
    *(u32x4*)&sm.k[buf][kr0][kc0 * 8] = RK0; *(u32x4*)&sm.k[buf][kr1][kc1 * 8] = RK1; *(u32x4*)&sm.k[buf][kr2][kc2 * 8] = RK2; } while (0)
#define ATT_VSTASH(buf) do { \
    *(u32x4*)&sm.vt[buf][vr0][vc0 * 8] = RV0; *(u32x4*)&sm.vt[buf][vr0 + 32][vc0 * 8] = RV1; } while (0)
#define ATT_S(SD, buf) do { \
      _Pragma("unroll") for (int kb = 0; kb < 2; kb++) { \
        { const bf16x8 kf0 = *(const bf16x8*)&sm.k[buf][kb * 32 + r][h * 8]; \
          SD[kb] = __builtin_amdgcn_mfma_f32_32x32x16_bf16(kf0, bq[0], zero16, 0, 0, 0); } \
        _Pragma("unroll") for (int s = 1; s < 6; s++) { \
          const bf16x8 kf = *(const bf16x8*)&sm.k[buf][kb * 32 + r][s * 16 + h * 8]; \
          SD[kb] = __builtin_amdgcn_mfma_f32_32x32x16_bf16(kf, bq[s], SD[kb], 0, 0, 0); \
        } \
      } } while (0)
#define ATT_SMPV(sacc, kt, buf) do { \
      const int k0 = (kt) << 6; \
      if (k0 + 63 > qw) { \
        _Pragma("unroll") for (int kb = 0; kb < 2; kb++) \
          _Pragma("unroll") for (int g = 0; g < 16; g++) { \
            const int key = k0 + kb * 32 + (g & 3) + 8 * (g >> 2) + 4 * h; \
            if (key > qg) sacc[kb][g] = -1e30f; \
          } \
      } \
      float mloc = -1e30f; \
      _Pragma("unroll") for (int kb = 0; kb < 2; kb++) \
        _Pragma("unroll") for (int g = 0; g < 16; g++) mloc = fmaxf(mloc, sacc[kb][g]); \
      mloc = fmaxf(mloc, __shfl_xor(mloc, 32, 64)); \
      const float m_new = fmaxf(m_run, mloc); \
      if (__any(m_new > m_run)) { \
        const float alpha = __builtin_amdgcn_exp2f(m_run - m_new); \
        l_run *= alpha; \
        _Pragma("unroll") for (int g = 0; g < 16; g++) { oacc[0][g] *= alpha; oacc[1][g] *= alpha; } \
        m_run = m_new; \
      } \
      float psum = 0.f; \
      _Pragma("unroll") for (int kb = 0; kb < 2; kb++) \
        _Pragma("unroll") for (int g = 0; g < 16; g++) { \
          const float pv = __builtin_amdgcn_exp2f(sacc[kb][g] - m_run); \
          sacc[kb][g] = pv; \
          psum += pv; \
        } \
      l_run += psum; \
      _Pragma("unroll") for (int kb = 0; kb < 2; kb++) \
        _Pragma("unroll") for (int sp = 0; sp < 2; sp++) { \
          uint4 pk; \
          pk.x = pack2(sacc[kb][8 * sp + 0], sacc[kb][8 * sp + 1]); \
          pk.y = pack2(sacc[kb][8 * sp + 2], sacc[kb][8 * sp + 3]); \
          pk.z = pack2(sacc[kb][8 * sp + 4], sacc[kb][8 * sp + 5]); \
          pk.w = pack2(sacc[kb][8 * sp + 6], sacc[kb][8 * sp + 7]); \
          const bf16x8 pf = __builtin_bit_cast(bf16x8, pk); \
          _Pragma("unroll") for (int db = 0; db < 2; db++) { \
            const s16x4 lo = *(const s16x4*)&sm.vt[buf][db * 32 + r][kb * 32 + 16 * sp + 4 * h]; \
            const s16x4 hi = *(const s16x4*)&sm.vt[buf][db * 32 + r][kb * 32 + 16 * sp + 8 + 4 * h]; \
            const bf16x8 vf = __builtin_shufflevector(lo, hi, 0, 1, 2, 3, 4, 5, 6, 7); \
            oacc[db] = __builtin_amdgcn_mfma_f32_32x32x16_bf16(vf, pf, oacc[db], 0, 0, 0); \
          } \
        } \
    } while (0)
#define ATT_ITER(kt, SC, SN, par) do { \
    ATT_KSTASH((par) ^ 1); \
    ATT_VSTASH(par); \
    __syncthreads(); \
    ATT_KISSUE((kt) + 2); \
    ATT_VISSUE((kt) + 1); \
    if ((kt) + 1 < nkt && (((kt) + 1) << 6) <= qw + 31) ATT_S(SN, (par) ^ 1); \
    if (((kt) << 6) <= qw + 31) ATT_SMPV(SC, kt, par); \
  } while (0)
  f32x16 SA[2], SB[2];
  ATT_KISSUE(0);
  __syncthreads();
  ATT_KSTASH(0);
  __syncthreads();
  ATT_KISSUE(1);
  ATT_VISSUE(0);
  ATT_S(SA, 0);
#pragma unroll 1
  for (int kt = 0; kt < nkt; kt += 2) {
    ATT_ITER(kt, SA, SB, 0);
    ATT_ITER(kt + 1, SB, SA, 1);
  }
  const float l_tot = l_run + __shfl_xor(l_run, 32, 64);
  const float inv_l = 1.f / l_tot;
  const size_t t = (size_t)b * SEQ + qg;
#pragma unroll
  for (int db = 0; db < 2; db++)
#pragma unroll
    for (int gq = 0; gq < 4; gq++) {
      const int d = db * 32 + 8 * gq + 4 * h;
      const uint2 z = *(const uint2*)(SZB + t * 512 + hh * 64 + d);
      const float z0 = __uint_as_float(z.x << 16), z1 = __uint_as_float(z.x & 0xffff0000u);
      const float z2 = __uint_as_float(z.y << 16), z3 = __uint_as_float(z.y & 0xffff0000u);
      uint2 o;
      o.x = pack2(oacc[db][4 * gq + 0] * inv_l * z0, oacc[db][4 * gq + 1] * inv_l * z1);
      o.y = pack2(oacc[db][4 * gq + 2] * inv_l * z2, oacc[db][4 * gq + 3] * inv_l * z3);
      *(uint2*)(O + t * LDY + hh * 64 + d) = o;
    }
#endif
}

DI void phase4(const Params& p, Smem& sm, int* cnt, int mode = 0) {
  __shared__ int s_v;
  const unsigned xcc = xcc_id();
  if (threadIdx.x == 0) s_v = atomicExch(&cnt[64 + xcc * 256 + cu_key()], 1);
  __syncthreads();
  const bool scan_first = (s_v == 0);
  __syncthreads();
  if (scan_first && mode != 2) {
    if (threadIdx.x == 0) s_v = atomicAdd(&cnt[8], 1);
    __syncthreads();
    const int item = s_v;
    __syncthreads();
    if (item < 256) {
      __builtin_amdgcn_s_setprio(3);
      scan_item(p, item, sm.sc);
      __builtin_amdgcn_s_setprio(0);
    }
  }
  QState qs; qs.q = (int)xcc; qs.tried = 0;
  if (mode != 1) for (;;) {
    const int li = fetch_item(cnt, 256, qs);
    if (li < 0) break;
    attn_item(p, qs.q * 8 + (li >> 5), 31 - (li & 31), sm.at);
  }
  if (mode != 2) for (;;) {
    __syncthreads();
    if (threadIdx.x == 0) s_v = atomicAdd(&cnt[8], 1);
    __syncthreads();
    const int item = s_v;
    if (item >= 256) break;
    scan_item(p, item, sm.sc);
  }
}

DI void phase5(const Params& p) {
  const long gtid = (long)blockIdx.x * 256 + threadIdx.x, nth = (long)gridDim.x * 256;
  const int lane = threadIdx.x & 63, sub = lane >> 4, l16 = lane & 15;
  const long wave = gtid >> 6, nw = nth >> 6;
  char* ws = p.ws;
  const u16* FA = (const u16*)(ws + O_FA);
  const u16* SZA = (const u16*)(ws + O_SZA);
  const float* BONUS = (const float*)(ws + O_BONUS);
  u16* Y = (u16*)((char*)p.out + D_YA);
  for (long it = wave; it < (long)T * 2; it += nw) {
    const long item = it * 4 + sub;
    const long t = item >> 3;
    const int hh = (int)(item & 7), c = hh * 64 + l16 * 4;
    const int s = (int)(t & (SEQ - 1));
    const float4 y = ld4(Y + t * LDY + c);
    const float mean = row16_sum((y.x + y.y) + (y.z + y.w)) * (1.f / 64.f);
    const float d0 = y.x - mean, d1 = y.y - mean, d2 = y.z - mean, d3 = y.w - mean;
    const float var = row16_sum((d0 * d0 + d1 * d1) + (d2 * d2 + d3 * d3)) * (1.f / 64.f);
    const float rstd = rsqrtf(var + GN_EPS);
    const float4 gg = *(const float4*)(p.gn_g + c), gb = *(const float4*)(p.gn_b + c), mu = *(const float4*)(p.mu + 1024 + c);
    const float4 vf = ld4(FA + t * FAW + 1024 + c);
    float4 vp = ld4(FA + (s > 0 ? t - 1 : t) * FAW + 1024 + c);
    if (s == 0) vp = make_float4(0.f, 0.f, 0.f, 0.f);
    const float bon = BONUS[t * 8 + hh];
    const float4 z = ld4(SZA + t * 512 + c);
    float4 o;
    o.x = (d0 * rstd * gg.x + gb.x + bon * (vf.x + mu.x * (vp.x - vf.x))) * z.x;
    o.y = (d1 * rstd * gg.y + gb.y + bon * (vf.y + mu.y * (vp.y - vf.y))) * z.y;
    o.z = (d2 * rstd * gg.z + gb.z + bon * (vf.z + mu.z * (vp.z - vf.z))) * z.z;
    o.w = (d3 * rstd * gg.w + gb.w + bon * (vf.w + mu.w * (vp.w - vf.w))) * z.w;
    st4(Y + t * LDY + c, o);
  }
}

DI void phase6(const Params& p, Smem& sm, int* cnt) {
  char* ws = p.ws;
  const u16* YA = (const u16*)((char*)p.out + D_YA);
  const u16* O = (const u16*)((char*)p.out + D_O);
  const u16* G = (const u16*)(ws + O_G);
  u16* MG = (u16*)(ws + O_U);
  const int xcd = blockIdx.x & 7, lb = blockIdx.x >> 3, nlb = gridDim.x >> 3;
  for (int li = lb; li < 256; li += nlb) {
    const int mt = xcd * 32 + (li >> 3), nt = li & 7;
    f32x16 acc[2][2];
    acc_zero(acc);
    u32 pk1[2][2][8];
    gemm_tile_dual(YA, (const u16*)(ws + O_WOA), O, (const u16*)(ws + O_WOB), LDY, LDY, mt * 128, nt * 128, acc, pk1, sm.g);
    acc_epilogue2(pk1, acc, mt * 128, nt * 128, sm.g, [&](int row, int col, float4 va, float4 vb) {
      const float4 ga = ld4(G + (size_t)row * LDG + col);
      const float4 gb = ld4(G + (size_t)row * LDG + 1024 + col);
      st4(MG + (size_t)row * LDU + col, make_float4(va.x * ga.x + vb.x * gb.x, va.y * ga.y + vb.y * gb.y,
                                                   va.z * ga.z + vb.z * gb.z, va.w * ga.w + vb.w * gb.w));
    });
  }
}

DI void phase7(const Params& p, Smem& sm, int* cnt) {
  char* ws = p.ws;
  const u16* MG = (const u16*)(ws + O_U);
  u16* TP = (u16*)(ws + O_FA);
  const int xcd = blockIdx.x & 7, lb = blockIdx.x >> 3, nlb = gridDim.x >> 3;
  for (int li = lb; li < 256; li += nlb) {
    const int mt = xcd * 32 + (li >> 3), nt = li & 7;
    f32x16 acc[2][2];
    acc_zero(acc);
    gemm_tile_acc(MG, LDU, (const u16*)(ws + O_WO), LDU, 1024, mt * 128, nt * 128, acc, sm.g);
    acc_epilogue(acc, mt * 128, nt * 128, sm.g, [&](int row, int col, float4 v) { st4(TP + (size_t)row * LDU + col, v); });
  }
}

DI void phase8(const Params& p) {
  int bz;
  asm volatile("v_mov_b32 %0, 0" : "=v"(bz));
  const long gtid = (long)(blockIdx.x + bz) * 256 + threadIdx.x, nth = (long)gridDim.x * 256;
  const int lane = threadIdx.x & 63;
  const long wave = gtid >> 6, nw = nth >> 6;
  const u16* TP = (const u16*)(p.ws + O_FA);
  for (long row = wave; row < T; row += nw) {
    float v[16];
    float ss = 0.f;
#pragma unroll
    for (int i = 0; i < 2; i++) {
      const uint4 u = *(const uint4*)(TP + row * LDU + i * 512 + lane * 8);
      v[i * 8 + 0] = __uint_as_float(u.x << 16); v[i * 8 + 1] = __uint_as_float(u.x & 0xffff0000u);
      v[i * 8 + 2] = __uint_as_float(u.y << 16); v[i * 8 + 3] = __uint_as_float(u.y & 0xffff0000u);
      v[i * 8 + 4] = __uint_as_float(u.z << 16); v[i * 8 + 5] = __uint_as_float(u.z & 0xffff0000u);
      v[i * 8 + 6] = __uint_as_float(u.w << 16); v[i * 8 + 7] = __uint_as_float(u.w & 0xffff0000u);
    }
#pragma unroll
    for (int i = 0; i < 16; i++) ss += v[i] * v[i];
    ss = wave_sum(ss);
    const float rs = rsqrtf(ss * (1.f / 1024.f) + NORM_EPS);
#pragma unroll
    for (int i = 0; i < 4; i++) {
      const int c = (i >> 1) * 512 + lane * 8 + (i & 1) * 4;
      const float4 g = *(const float4*)(p.g_post + c);
      const float4 xx = *(const float4*)(p.x + row * 1024 + c);
      float4 o;
      o.x = xx.x + v[i * 4 + 0] * rs * g.x; o.y = xx.y + v[i * 4 + 1] * rs * g.y;
      o.z = xx.z + v[i * 4 + 2] * rs * g.z; o.w = xx.w + v[i * 4 + 3] * rs * g.w;
      *(float4*)(p.out + row * 1024 + c) = o;
    }
  }
}

__global__ void __launch_bounds__(256, 2) fwd_megakernel(Params p) {
  cg::grid_group grid = cg::this_grid();
  __shared__ Smem sm;
  int* cnt = (int*)(p.ws + O_CNT);
  GBar gb;
  gbar_init(gb, (unsigned*)(p.ws + O_CNT) + 12288);
  if (p.never) grid.sync();
#define GSYNC() gbar_sync(gb)
  phase0(p);
  GSYNC();
  if (PROBE == 0) { phase0(p); GSYNC(); }
  phase1(p, sm, cnt);
  GSYNC();
  if (PROBE == 1) { phase1(p, sm, cnt + 4096); GSYNC(); }
  phase2(p);
  GSYNC();
  if (PROBE == 2) { phase2(p); GSYNC(); }
  phase3(p, sm, cnt + 8);
  GSYNC();
  if (PROBE == 3) { phase3(p, sm, cnt + 4096); GSYNC(); }
  if (PROBE == 41) { phase4(p, sm, cnt + 4096, 1); GSYNC(); }
  if (PROBE == 42) { phase4(p, sm, cnt + 4096, 2); GSYNC(); }
  phase4(p, sm, cnt + 1024);
  GSYNC();
  if (PROBE == 4) { phase4(p, sm, cnt + 4096); GSYNC(); }
  phase5(p);
  GSYNC();
  phase6(p, sm, cnt + 16);
  GSYNC();
  if (PROBE == 6) { phase6(p, sm, cnt + 4096); GSYNC(); }
  phase7(p, sm, cnt + 24);
  GSYNC();
  if (PROBE == 7) { phase7(p, sm, cnt + 4096); GSYNC(); }
  if (PROBE == 80) { for (int rep = 0; rep < 8; rep++) GSYNC(); }
  phase8(p);
}

extern "C" void kernel_launch(void* const* d_in, const int* in_sizes, int n_in,
                              void* d_out, int out_size, void* d_ws, size_t ws_size,
                              hipStream_t stream) {
  static int grid_blocks = 0;
  if (!grid_blocks) {
    int dev = 0, cus = 0, per_cu = 0;
    hipGetDevice(&dev);
    hipDeviceGetAttribute(&cus, hipDeviceAttributeMultiprocessorCount, dev);
    hipOccupancyMaxActiveBlocksPerMultiprocessor(&per_cu, fwd_megakernel, 256, 0);
    if (per_cu > 2) per_cu = 2;
    if (per_cu < 1) per_cu = 1;
    grid_blocks = cus * per_cu;
  }
  if (ws_size < WS_NEED) { fprintf(stderr, "workspace too small: %zu < %zu\n", ws_size, (size_t)WS_NEED); return; }
  Params p{};
  p.x = (const float*)d_in[0]; p.pos = (const int*)d_in[1]; p.g_pre = (const float*)d_in[2]; p.w_in = (const float*)d_in[3];
  p.b_gate = (const float*)d_in[4]; p.mu = (const float*)d_in[5]; p.w0 = (const float*)d_in[6]; p.w_dec = (const float*)d_in[7];
  p.a0 = (const float*)d_in[8]; p.w_icl = (const float*)d_in[9]; p.k_k = (const float*)d_in[10]; p.k_a = (const float*)d_in[11];
  p.r_k = (const float*)d_in[12]; p.gn_g = (const float*)d_in[13]; p.gn_b = (const float*)d_in[14]; p.w_oa = (const float*)d_in[15];
  p.g_q = (const float*)d_in[16]; p.w_uq = (const float*)d_in[17]; p.g_kv = (const float*)d_in[18]; p.w_ukv = (const float*)d_in[19];
  p.w_ob = (const float*)d_in[20]; p.w_o = (const float*)d_in[21]; p.g_post = (const float*)d_in[22];
  p.out = (float*)d_out; p.ws = (char*)d_ws;
  p.never = 0;
  (void)hipMemsetAsync((char*)d_ws + O_CNT, 0, 65536, stream);
  void* args[] = {&p};
  hipError_t e = hipLaunchCooperativeKernel((void*)fwd_megakernel, dim3(grid_blocks), dim3(256), args, 0, stream);
  if (e != hipSuccess) fprintf(stderr, "cooperative launch failed: %s (grid %d)\n", hipGetErrorString(e), grid_blocks);
}
```

```cpp
#include <hip/hip_runtime.h>
#include <hip/hip_cooperative_groups.h>
#include <cstdio>
namespace cg = cooperative_groups;

#ifndef PROBE
#define PROBE -1
#endif
#ifndef NAIVE_GEMM
#define NAIVE_GEMM 0
#endif
#ifndef NAIVE_ATTN
#define NAIVE_ATTN 0
#endif

typedef unsigned short u16;
typedef unsigned int u32;
typedef __attribute__((ext_vector_type(8))) short bf16x8;
typedef __attribute__((ext_vector_type(4))) short s16x4;
typedef __attribute__((ext_vector_type(16))) float f32x16;
#define DI __device__ __forceinline__

constexpr int T = 32768, SEQ = 4096, NB = 8, DM = 1024;
constexpr int INC = 5152, INP = 5248;
constexpr int FAW = 1664;
constexpr int C_ZA = 1664, C_CQ = 2176, C_ZB = 2592, C_G = 3104;
constexpr int LDU = 1088, LDY = 576, LDG = 2112, LDV = 4160, LDQW = 320;
constexpr int CQW = 416;
constexpr float DECAY_SCALE = 0.6065306597f;
constexpr float GN_EPS = 64e-5f;
constexpr float NORM_EPS = 1e-6f;

constexpr size_t O_WIN = 0;
constexpr size_t O_WUQ = O_WIN + (size_t)INP * LDU * 2;
constexpr size_t O_WUKV = O_WUQ + 768 * LDQW * 2;
constexpr size_t O_WOA = O_WUKV + 1024 * 128 * 2;
constexpr size_t O_WOB = O_WOA + 1024 * LDY * 2;
constexpr size_t O_WO = O_WOB + 1024 * LDY * 2;
constexpr size_t O_WDEC = O_WO + 1024 * LDU * 2;
constexpr size_t O_WICL = O_WDEC + 512 * 64 * 2;
constexpr size_t O_RSQ = O_WICL + 512 * 64 * 2;
constexpr size_t O_RSKV = O_RSQ + (size_t)T * 4;
constexpr size_t O_BONUS = O_RSKV + (size_t)T * 4;
constexpr size_t O_CS = O_BONUS + (size_t)T * 8 * 4;
constexpr size_t O_CNT = O_CS + (size_t)T * 32 * 4;
constexpr size_t O_U = O_CNT + 65536;
constexpr size_t O_FA = O_U + (size_t)T * LDU * 2;
constexpr size_t O_SZA = O_FA + (size_t)T * FAW * 2;
constexpr size_t O_SZB = O_SZA + (size_t)T * 512 * 2;
constexpr size_t O_CQKV = O_SZB + (size_t)T * 512 * 2;
constexpr size_t O_G = O_CQKV + (size_t)T * CQW * 2;
constexpr size_t O_Q = O_G + (size_t)T * LDG * 2;
constexpr size_t O_K = O_Q + (size_t)T * 768 * 2;
constexpr size_t WS_NEED = O_K + (size_t)T * 768 * 2;
static_assert(WS_NEED <= (size_t)536870912, "workspace budget");
constexpr size_t D_YA = 0;
constexpr size_t D_O = D_YA + (size_t)T * LDY * 2;
constexpr size_t D_VT = D_O + (size_t)T * LDY * 2;
constexpr size_t D_LA = D_VT + (size_t)64 * 64 * LDV * 2;
static_assert(D_LA + (size_t)T * 128 * 2 <= (size_t)T * 1024 * 4, "d_out scratch budget");

struct Params {
  const float* x; const int* pos; const float* g_pre; const float* w_in; const float* b_gate; const float* mu;
  const float* w0; const float* w_dec; const float* a0; const float* w_icl; const float* k_k; const float* k_a;
  const float* r_k; const float* gn_g; const float* gn_b; const float* w_oa; const float* g_q; const float* w_uq;
  const float* g_kv; const float* w_ukv; const float* w_ob; const float* w_o; const float* g_post;
  float* out; char* ws; long never;
};

DI u16 f2bf(float x) { u32 u = __float_as_uint(x); u += 0x7fffu + ((u >> 16) & 1u); return (u16)(u >> 16); }
DI float bf2f(u16 b) { return __uint_as_float(((u32)b) << 16); }
typedef __attribute__((ext_vector_type(2))) float f32x2;
typedef __attribute__((ext_vector_type(2))) __bf16 bf16x2_t;
DI u32 pack2(float a, float b) { f32x2 v = {a, b}; bf16x2_t q = __builtin_convertvector(v, bf16x2_t); return __builtin_bit_cast(u32, q); }
DI void st4(u16* p, float4 v) { uint2 o; o.x = pack2(v.x, v.y); o.y = pack2(v.z, v.w); *(uint2*)p = o; }
DI float4 ld4(const u16* p) { const uint2 u = *(const uint2*)p; return make_float4(__uint_as_float(u.x << 16), __uint_as_float(u.x & 0xffff0000u), __uint_as_float(u.y << 16), __uint_as_float(u.y & 0xffff0000u)); }
DI float sigmoidf_(float x) { return __builtin_amdgcn_rcpf(1.f + __expf(-x)); }
DI float siluf_(float x) { return x * __builtin_amdgcn_rcpf(1.f + __expf(-x)); }
DI float wave_sum(float v) {
#pragma unroll
  for (int o = 32; o > 0; o >>= 1) v += __shfl_xor(v, o, 64);
  return v;
}
template <int CTRL> DI float dpp_mov(float x) {
  return __builtin_bit_cast(float, __builtin_amdgcn_update_dpp(0, __builtin_bit_cast(int, x), CTRL, 0xf, 0xf, true));
}
DI float row16_sum(float x) {
  x += dpp_mov<0xB1>(x);
  x += dpp_mov<0x4E>(x);
  x += dpp_mov<0x141>(x);
  x += dpp_mov<0x140>(x);
  return x;
}


DI unsigned xcc_id() { return (unsigned)__builtin_amdgcn_s_getreg((3 << 11) | 20) & 0x7u; }
DI unsigned cu_key() { return ((unsigned)__builtin_amdgcn_s_getreg(63492) >> 8) & 0xffu; }
struct QState { int q, tried; };
DI int fetch_item(int* cnt, int per_q, QState& st) {
  __shared__ int s_q, s_tr, s_it;
  __syncthreads();
  if (threadIdx.x == 0) {
    int qq = st.q, tr = st.tried, it = -1;
    while (tr < 8) {
      it = atomicAdd(&cnt[qq], 1);
      if (it < per_q) break;
      it = -1; qq = (qq + 1) & 7; tr++;
    }
    s_q = qq; s_tr = tr; s_it = it;
  }
  __syncthreads();
  st.q = s_q; st.tried = s_tr;
  return s_it;
}


#define XB_XCNT(j) (64 * (j))
#define XB_XSUB(j) (512 + 64 * (j))
#define XB_XGEN(j) (1024 + 64 * (j))
#define XB_TOP 1536
#define XB_TOPGEN 1600
DI unsigned xb_ld(unsigned* p) { return __hip_atomic_load(p, __ATOMIC_RELAXED, __HIP_MEMORY_SCOPE_AGENT); }
DI unsigned xb_add(unsigned* p, unsigned v) { return __hip_atomic_fetch_add(p, v, __ATOMIC_RELAXED, __HIP_MEMORY_SCOPE_AGENT); }
struct GBar { unsigned* bar; unsigned x, nloc, nx; };
DI void gbar_init(GBar& g, unsigned* bar) {
  g.bar = bar; g.x = xcc_id(); g.nloc = 0; g.nx = 0;
  if (threadIdx.x == 0) (void)xb_add(&bar[XB_XCNT(g.x)], 1u);
}
DI void gbar_sync(GBar& g) {
  asm volatile("s_waitcnt vmcnt(0)" ::: "memory");
  __syncthreads();
  if (threadIdx.x == 0) {
    unsigned* bar = g.bar;
    if (g.nloc == 0u) {
      unsigned sum, cnt, mine;
      for (;;) {
        sum = 0u; cnt = 0u; mine = 0u;
#pragma unroll
        for (unsigned j = 0; j < 8; ++j) { const unsigned c = xb_ld(&bar[XB_XCNT(j)]); sum += c; cnt += (c > 0u) ? 1u : 0u; mine = (j == g.x) ? c : mine; }
        if (sum == gridDim.x) break;
        __builtin_amdgcn_s_sleep(1);
      }
      g.nloc = mine; g.nx = cnt;
    }
    const unsigned old = xb_add(&bar[XB_XSUB(g.x)], 1u);
    const unsigned gen = old / g.nloc;
    if (old + 1u == (gen + 1u) * g.nloc) {
      __builtin_amdgcn_fence(__ATOMIC_RELEASE, "agent");
      asm volatile("s_waitcnt vmcnt(0)" ::: "memory");
      const unsigned og = xb_add(&bar[XB_TOP], 1u);
      const unsigned tg = og / g.nx;
      if (og + 1u == (tg + 1u) * g.nx) xb_add(&bar[XB_TOPGEN], 1u);
      else while (xb_ld(&bar[XB_TOPGEN]) == tg) __builtin_amdgcn_s_sleep(1);
      __builtin_amdgcn_fence(__ATOMIC_ACQUIRE, "agent");
      xb_add(&bar[XB_XGEN(g.x)], 1u);
      asm volatile("s_waitcnt vmcnt(0)" ::: "memory");
    } else {
      while (xb_ld(&bar[XB_XGEN(g.x)]) == gen) __builtin_amdgcn_s_sleep(1);
      __builtin_amdgcn_fence(__ATOMIC_ACQUIRE, "agent");
      asm volatile("s_waitcnt vmcnt(0)" ::: "memory");
    }
  }
  __syncthreads();
}

struct SmemGemm { u16 a[2][128][72]; u16 b[2][128][72]; };
struct SmemAttn { u16 k[2][64][104]; u16 vt[2][64][72]; };
struct SmemScan { float vec[2][16][5][64]; float v[2][16][16]; float yp[16][16][16]; };
union __attribute__((aligned(16))) Smem { SmemGemm g; SmemAttn at; SmemScan sc; };

typedef __attribute__((ext_vector_type(4))) unsigned int u32x4;
#define G_LOAD(R, k0) do { \
    R##a0 = *(const u32x4*)(Ap + (k0)); R##a1 = *(const u32x4*)(Ap + sa32 + (k0)); R##a2 = *(const u32x4*)(Ap + 2 * sa32 + (k0)); R##a3 = *(const u32x4*)(Ap + 3 * sa32 + (k0)); \
    R##b0 = *(const u32x4*)(Bp + (k0)); R##b1 = *(const u32x4*)(Bp + sb32 + (k0)); R##b2 = *(const u32x4*)(Bp + 2 * sb32 + (k0)); R##b3 = *(const u32x4*)(Bp + 3 * sb32 + (k0)); } while (0)
#define G_STORE(buf, R) do { \
    *(u32x4*)&sm.a[buf][lrow][lkc] = R##a0; *(u32x4*)&sm.a[buf][lrow + 32][lkc] = R##a1; *(u32x4*)&sm.a[buf][lrow + 64][lkc] = R##a2; *(u32x4*)&sm.a[buf][lrow + 96][lkc] = R##a3; \
    *(u32x4*)&sm.b[buf][lrow][lkc] = R##b0; *(u32x4*)&sm.b[buf][lrow + 32][lkc] = R##b1; *(u32x4*)&sm.b[buf][lrow + 64][lkc] = R##b2; *(u32x4*)&sm.b[buf][lrow + 96][lkc] = R##b3; } while (0)
#define G_COMPUTE_LOW(buf) do {     \
    _Pragma("unroll") for (int s = 0; s < 4; s++) { \
      bf16x8 af[2], bfr[2]; \
      _Pragma("unroll") for (int i = 0; i < 2; i++) af[i] = *(const bf16x8*)&sm.a[buf][wm * 64 + i * 32 + r][s * 16 + h * 8]; \
      _Pragma("unroll") for (int j = 0; j < 2; j++) bfr[j] = *(const bf16x8*)&sm.b[buf][wn * 64 + j * 32 + r][s * 16 + h * 8]; \
      _Pragma("unroll") for (int i = 0; i < 2; i++) \
        _Pragma("unroll") for (int j = 0; j < 2; j++) acc[i][j] = __builtin_amdgcn_mfma_f32_32x32x16_bf16(af[i], bfr[j], acc[i][j], 0, 0, 0); \
    } } while (0)
#define G_COMPUTE(buf) do { \
    if (VAR == 1) { G_COMPUTE_LOW(buf); break; } \
    _Pragma("unroll") for (int hs = 0; hs < 2; hs++) {     \
      bf16x8 af[2][2], bfr[2][2]; \
      _Pragma("unroll") for (int s = 0; s < 2; s++) { \
        _Pragma("unroll") for (int i = 0; i < 2; i++) af[s][i] = *(const bf16x8*)&sm.a[buf][wm * 64 + i * 32 + r][(hs * 2 + s) * 16 + h * 8]; \
        _Pragma("unroll") for (int j = 0; j < 2; j++) bfr[s][j] = *(const bf16x8*)&sm.b[buf][wn * 64 + j * 32 + r][(hs * 2 + s) * 16 + h * 8]; \
      } \
      __builtin_amdgcn_sched_barrier(0); \
      _Pragma("unroll") for (int s = 0; s < 2; s++) \
        _Pragma("unroll") for (int i = 0; i < 2; i++) \
          _Pragma("unroll") for (int j = 0; j < 2; j++) acc[i][j] = __builtin_amdgcn_mfma_f32_32x32x16_bf16(af[s][i], bfr[s][j], acc[i][j], 0, 0, 0); \
      __builtin_amdgcn_sched_barrier(0); \
    } \
  } while (0)
#define G_STEP(kt, bufc, bufn) do { \
    const int kl_ = ((kt) + 2 < nk) ? (kt) + 2 : nk - 1;     \
    G_COMPUTE(bufc); \
    G_STORE(bufn, R0); \
    G_LOAD(R0, kl_ << 6); \
    __syncthreads(); } while (0)

template <int VAR = 0> DI void gemm_tile_acc(const u16* __restrict__ A, int lda, const u16* __restrict__ Bt, int ldb, int K,
                      int m0, int n0, f32x16 (&acc)[2][2], SmemGemm& sm) {
  const int tid = threadIdx.x, lane = tid & 63, w = tid >> 6, wm = w >> 1, wn = w & 1, r = lane & 31, h = lane >> 5;
  const int lrow = tid >> 3, lkc = (tid & 7) * 8;
  const u16* Ap = A + (size_t)(m0 + lrow) * lda + lkc;
  const u16* Bp = Bt + (size_t)(n0 + lrow) * ldb + lkc;
  const size_t sa32 = (size_t)32 * lda, sb32 = (size_t)32 * ldb;
  const int nk = K >> 6;
  u32x4 R0a0, R0a1, R0a2, R0a3, R0b0, R0b1, R0b2, R0b3;
  G_LOAD(R0, 0);
  __syncthreads();
  G_STORE(0, R0);
  if (nk == 1) {
    __syncthreads();
    G_COMPUTE(0);
    __syncthreads();
    return;
  }
  G_LOAD(R0, 64);
  __syncthreads();
  __builtin_amdgcn_s_setprio(1);
#pragma unroll 1
  for (int kt = 0; kt < nk; kt += 2) {
    G_STEP(kt, 0, 1);
    G_STEP(kt + 1, 1, 0);
  }
  __builtin_amdgcn_s_setprio(0);
}

DI void gemm_tile_dual(const u16* __restrict__ A1, const u16* __restrict__ B1, const u16* __restrict__ A2, const u16* __restrict__ B2,
                       int lda, int ldb, int m0, int n0, f32x16 (&acc)[2][2], u32 (&pk1)[2][2][8], SmemGemm& sm) {
  constexpr int VAR = 1;
  const int tid = threadIdx.x, lane = tid & 63, w = tid >> 6, wm = w >> 1, wn = w & 1, r = lane & 31, h = lane >> 5;
  const int lrow = tid >> 3, lkc = (tid & 7) * 8;
  const u16* A1p = A1 + (size_t)(m0 + lrow) * lda + lkc;
  const u16* B1p = B1 + (size_t)(n0 + lrow) * ldb + lkc;
  const u16* A2p = A2 + (size_t)(m0 + lrow) * lda + lkc;
  const u16* B2p = B2 + (size_t)(n0 + lrow) * ldb + lkc;
  const size_t sa32 = (size_t)32 * lda, sb32 = (size_t)32 * ldb;
  constexpr int nk = 16;
  u32x4 R0a0, R0a1, R0a2, R0a3, R0b0, R0b1, R0b2, R0b3;
#define GD_LOAD(kl) do { const int kl_ = (kl) < nk ? (kl) : nk - 1; \
    const u16* Ap = (kl_ < 8) ? A1p : A2p; const u16* Bp = (kl_ < 8) ? B1p : B2p; G_LOAD(R0, (kl_ & 7) << 6); } while (0)
#define GD_STEP(kt, bufc, bufn) do { G_COMPUTE(bufc); G_STORE(bufn, R0); GD_LOAD((kt) + 2); __syncthreads(); } while (0)
  GD_LOAD(0);
  __syncthreads();
  G_STORE(0, R0);
  GD_LOAD(1);
  __syncthreads();
  __builtin_amdgcn_s_setprio(1);
#pragma unroll 1
  for (int kt = 0; kt < nk; kt += 2) {
    if (kt == 8) {
#pragma unroll
      for (int i = 0; i < 2; i++)
#pragma unroll
        for (int j = 0; j < 2; j++) {
#pragma unroll
          for (int q = 0; q < 8; q++) pk1[i][j][q] = pack2(acc[i][j][2 * q], acc[i][j][2 * q + 1]);
#pragma unroll
          for (int g = 0; g < 16; g++) acc[i][j][g] = 0.f;
        }
    }
    GD_STEP(kt, 0, 1);
    GD_STEP(kt + 1, 1, 0);
  }
  __builtin_amdgcn_s_setprio(0);
}

DI void acc_zero(f32x16 (&acc)[2][2]) {
#pragma unroll
  for (int i = 0; i < 2; i++)
#pragma unroll
    for (int j = 0; j < 2; j++)
#pragma unroll
      for (int g = 0; g < 16; g++) acc[i][j][g] = 0.f;
}

DI void acc_stage(f32x16 (&acc)[2][2], SmemGemm& sm) {
  const int lane = threadIdx.x & 63, w = threadIdx.x >> 6, r = lane & 31, h = lane >> 5;
  float* wb = (float*)&sm + w * (64 * 68);
#pragma unroll
  for (int i = 0; i < 2; i++)
#pragma unroll
    for (int j = 0; j < 2; j++)
#pragma unroll
      for (int g = 0; g < 16; g++)
        wb[(i * 32 + (g & 3) + 8 * (g >> 2) + 4 * h) * 68 + j * 32 + r] = acc[i][j][g];
  __syncthreads();
}
template <class F> DI void acc_drain(int m0, int n0, SmemGemm& sm, F f) {
  const int lane = threadIdx.x & 63, w = threadIdx.x >> 6, wm = w >> 1, wn = w & 1;
  const float* wb = (const float*)&sm + w * (64 * 68);
  const int rl = lane >> 4, c4 = (lane & 15) * 4;
#pragma unroll 4
  for (int it = 0; it < 16; it++) {
    const int row_l = it * 4 + rl;
    const float4 v = *(const float4*)&wb[row_l * 68 + c4];
    f(m0 + wm * 64 + row_l, n0 + wn * 64 + c4, v);
  }
}
template <class F> DI void acc_epilogue(f32x16 (&acc)[2][2], int m0, int n0, SmemGemm& sm, F f) {
  acc_stage(acc, sm);
  acc_drain(m0, n0, sm, f);
}

template <class F> DI void acc_epilogue2(const u32 (&pk1)[2][2][8], f32x16 (&acc2)[2][2], int m0, int n0, SmemGemm& sm, F f) {
  const int lane = threadIdx.x & 63, w = threadIdx.x >> 6, wm = w >> 1, wn = w & 1, r = lane & 31, h = lane >> 5;
  float* wb = (float*)&sm + w * (64 * 68);
  const int rl = lane >> 4, c4 = (lane & 15) * 4;
  int lz;
  asm volatile("v_mov_b32 %0, 0" : "=v"(lz));
  m0 += lz;
  uint2 v1[16];
#pragma unroll
  for (int i = 0; i < 2; i++)
#pragma unroll
    for (int j = 0; j < 2; j++)
#pragma unroll
      for (int q = 0; q < 8; q++) {
        const int g0 = 2 * q, g1 = 2 * q + 1;
        wb[(i * 32 + (g0 & 3) + 8 * (g0 >> 2) + 4 * h) * 68 + j * 32 + r] = __uint_as_float(pk1[i][j][q] << 16);
        wb[(i * 32 + (g1 & 3) + 8 * (g1 >> 2) + 4 * h) * 68 + j * 32 + r] = __uint_as_float(pk1[i][j][q] & 0xffff0000u);
      }
  __syncthreads();
#pragma unroll
  for (int it = 0; it < 16; it++) {
    const float4 t = *(const float4*)&wb[(it * 4 + rl) * 68 + c4];
    v1[it] = make_uint2(pack2(t.x, t.y), pack2(t.z, t.w));
  }
  __syncthreads();
#pragma unroll
  for (int i = 0; i < 2; i++)
#pragma unroll
    for (int j = 0; j < 2; j++)
#pragma unroll
      for (int g = 0; g < 16; g++)
        wb[(i * 32 + (g & 3) + 8 * (g >> 2) + 4 * h) * 68 + j * 32 + r] = acc2[i][j][g];
  __syncthreads();
#pragma unroll
  for (int it = 0; it < 16; it++) {
    const int row_l = it * 4 + rl;
    const float4 v2 = *(const float4*)&wb[row_l * 68 + c4];
    const float4 va = make_float4(__uint_as_float(v1[it].x << 16), __uint_as_float(v1[it].x & 0xffff0000u),
                                  __uint_as_float(v1[it].y << 16), __uint_as_float(v1[it].y & 0xffff0000u));
    f(m0 + wm * 64 + row_l, n0 + wn * 64 + c4, va, v2);
  }
}

DI float4 silu4(float4 v) { return make_float4(siluf_(v.x), siluf_(v.y), siluf_(v.z), siluf_(v.w)); }
DI float4 sigm4(float4 v) { return make_float4(sigmoidf_(v.x), sigmoidf_(v.y), sigmoidf_(v.z), sigmoidf_(v.w)); }

DI void transpose_cvt(const float* __restrict__ src, int K, int N, u16* __restrict__ dst, int ldd, const float* __restrict__ kscale,
                      long gtid, long nth) {
  const long tot = (long)(K >> 3) * N;
  for (long idx = gtid; idx < tot; idx += nth) {
    const int kb = (int)(idx / N), n = (int)(idx - (long)kb * N), k0 = kb * 8;
    float v[8];
#pragma unroll
    for (int j = 0; j < 8; j++) v[j] = src[(size_t)(k0 + j) * N + n];
    if (kscale) {
#pragma unroll
      for (int j = 0; j < 8; j++) v[j] *= kscale[k0 + j];
    }
    uint4 o;
    o.x = pack2(v[0], v[1]); o.y = pack2(v[2], v[3]); o.z = pack2(v[4], v[5]); o.w = pack2(v[6], v[7]);
    *(uint4*)(dst + (size_t)n * ldd + k0) = o;
  }
}

DI void phase0(const Params& p) {
  const long gtid = (long)blockIdx.x * 256 + threadIdx.x, nth = (long)gridDim.x * 256;
  char* ws = p.ws;
  transpose_cvt(p.w_in, 1024, INC, (u16*)(ws + O_WIN), LDU, nullptr, gtid, nth);
  for (long idx = gtid; idx < (long)(INP - INC) * LDU; idx += nth) ((u16*)(ws + O_WIN))[(size_t)INC * LDU + idx] = 0;
  transpose_cvt(p.w_uq, 256, 768, (u16*)(ws + O_WUQ), LDQW, p.g_q, gtid, nth);
  transpose_cvt(p.w_ukv, 128, 1024, (u16*)(ws + O_WUKV), 128, p.g_kv, gtid, nth);
  transpose_cvt(p.w_oa, 512, 1024, (u16*)(ws + O_WOA), LDY, nullptr, gtid, nth);
  transpose_cvt(p.w_ob, 512, 1024, (u16*)(ws + O_WOB), LDY, nullptr, gtid, nth);
  transpose_cvt(p.w_o, 1024, 1024, (u16*)(ws + O_WO), LDU, nullptr, gtid, nth);
  transpose_cvt(p.w_dec, 64, 512, (u16*)(ws + O_WDEC), 64, nullptr, gtid, nth);
  transpose_cvt(p.w_icl, 64, 512, (u16*)(ws + O_WICL), 64, nullptr, gtid, nth);

  const int lane = threadIdx.x & 63;
  const long wave = gtid >> 6, nw = nth >> 6;
  u16* U = (u16*)(ws + O_U);
  for (long row = wave; row < T; row += nw) {
    const float4* xr = (const float4*)(p.x + row * 1024);
    float4 v[4];
    float ss = 0.f;
#pragma unroll
    for (int i = 0; i < 4; i++) { v[i] = xr[lane + 64 * i]; ss += v[i].x * v[i].x + v[i].y * v[i].y + v[i].z * v[i].z + v[i].w * v[i].w; }
    ss = wave_sum(ss);
    const float rs = rsqrtf(ss * (1.f / 1024.f) + NORM_EPS);
#pragma unroll
    for (int i = 0; i < 4; i++) {
      float4 g = ((const float4*)p.g_pre)[lane + 64 * i];
      uint2 o;
      o.x = pack2(v[i].x * rs * g.x, v[i].y * rs * g.y);
      o.y = pack2(v[i].z * rs * g.z, v[i].w * rs * g.w);
      *(uint2*)(U + row * LDU + (lane + 64 * i) * 4) = o;
    }
  }
}

DI void phase1(const Params& p, Smem& sm, int* cnt) {
  char* ws = p.ws;
  const u16* U = (const u16*)(ws + O_U);
  const u16* W = (const u16*)(ws + O_WIN);
  u16* FA = (u16*)(ws + O_FA); u16* SZA = (u16*)(ws + O_SZA); u16* SZB = (u16*)(ws + O_SZB);
  u16* CQKV = (u16*)(ws + O_CQKV); u16* G = (u16*)(ws + O_G);
  const float* bg = p.b_gate;
  const int xcd = blockIdx.x & 7, lb = blockIdx.x >> 3, nlb = gridDim.x >> 3;
  for (int li = lb; li < 32 * 41; li += nlb) {
    const int g = li / 328, rem = li - g * 328, nt = rem >> 3, mt = xcd * 32 + g * 8 + (rem & 7);
    f32x16 acc[2][2];
    acc_zero(acc);
    gemm_tile_acc(U, LDU, W, LDU, 1024, mt * 128, nt * 128, acc, sm.g);
    acc_stage(acc, sm.g);
    const int cw = __builtin_amdgcn_readfirstlane(nt * 128 + ((threadIdx.x >> 6) & 1) * 64);
    const int m0 = mt * 128, n0 = nt * 128;
    if (cw + 64 <= C_ZA) {
      acc_drain(m0, n0, sm.g, [&](int row, int col, float4 v) { st4(FA + (size_t)row * FAW + col, v); });
    } else if (cw >= C_ZA && cw + 64 <= C_CQ) {
      acc_drain(m0, n0, sm.g, [&](int row, int col, float4 v) { st4(SZA + (size_t)row * 512 + (col - C_ZA), silu4(v)); });
    } else if (cw >= C_ZB && cw + 64 <= C_G) {
      acc_drain(m0, n0, sm.g, [&](int row, int col, float4 v) { st4(SZB + (size_t)row * 512 + (col - C_ZB), silu4(v)); });
    } else if (cw >= C_G && cw + 64 <= INC) {
      acc_drain(m0, n0, sm.g, [&](int row, int col, float4 v) {
        const float4 bb = *(const float4*)(bg + (col - C_G));
        st4(G + (size_t)row * LDG + (col - C_G), sigm4(make_float4(v.x + bb.x, v.y + bb.y, v.z + bb.z, v.w + bb.w)));
      });
    } else {
      acc_drain(m0, n0, sm.g, [&](int row, int col, float4 v) {
        if (col < C_ZA) st4(FA + (size_t)row * FAW + col, v);
        else if (col < C_CQ) st4(SZA + (size_t)row * 512 + (col - C_ZA), silu4(v));
        else if (col < C_ZB) st4(CQKV + (size_t)row * CQW + (col - C_CQ), v);
        else if (col < C_G) st4(SZB + (size_t)row * 512 + (col - C_ZB), silu4(v));
        else if (col < INC) {
          const float4 bb = *(const float4*)(bg + (col - C_G));
          st4(G + (size_t)row * LDG + (col - C_G), sigm4(make_float4(v.x + bb.x, v.y + bb.y, v.z + bb.z, v.w + bb.w)));
        }
      });
    }
  }
}

DI void phase2(const Params& p) {
  const long gtid = (long)blockIdx.x * 256 + threadIdx.x, nth = (long)gridDim.x * 256;
  const int lane = threadIdx.x & 63, sub = lane >> 4, l16 = lane & 15;
  const long wave = gtid >> 6, nw = nth >> 6;
  char* ws = p.ws;
  const u16* FA = (const u16*)(ws + O_FA);
  const u16* CQKV = (const u16*)(ws + O_CQKV);
  u16* LA = (u16*)((char*)p.out + D_LA);
  u16* Kb = (u16*)(ws + O_K);
  float* RSQ = (float*)(ws + O_RSQ); float* RSKV = (float*)(ws + O_RSKV);
  float* CS = (float*)(ws + O_CS);
  const float4 mu_wd = *(const float4*)(p.mu + 1536 + l16 * 4), mu_ad = *(const float4*)(p.mu + 1600 + l16 * 4);
  const float inv_freq = powf(10000.0f, -(float)l16 / 16.0f);
  for (long it = wave; it < T / 4; it += nw) {
    const long t = it * 4 + sub;
    const int s = (int)(t & (SEQ - 1)), b = (int)(t >> 12);
    const u16* fa = FA + t * FAW;
    const u16* fp = (s > 0) ? fa - FAW : fa;
    {
      const float4 f = ld4(fa + 1536 + l16 * 4);
      float4 pv = ld4(fp + 1536 + l16 * 4);
      if (s == 0) pv = make_float4(0.f, 0.f, 0.f, 0.f);
      st4(LA + t * 128 + l16 * 4, make_float4(tanhf(f.x + mu_wd.x * (pv.x - f.x)), tanhf(f.y + mu_wd.y * (pv.y - f.y)),
                                              tanhf(f.z + mu_wd.z * (pv.z - f.z)), tanhf(f.w + mu_wd.w * (pv.w - f.w))));
      const float4 f2 = ld4(fa + 1600 + l16 * 4);
      float4 pv2 = ld4(fp + 1600 + l16 * 4);
      if (s == 0) pv2 = make_float4(0.f, 0.f, 0.f, 0.f);
      st4(LA + t * 128 + 64 + l16 * 4, make_float4(f2.x + mu_ad.x * (pv2.x - f2.x), f2.y + mu_ad.y * (pv2.y - f2.y),
                                                   f2.z + mu_ad.z * (pv2.z - f2.z), f2.w + mu_ad.w * (pv2.w - f2.w)));
    }
    const u16* c = CQKV + t * CQW;
    float ss = 0.f, ss2 = 0.f;
#pragma unroll
    for (int i = 0; i < 4; i++) { const float4 v = ld4(c + i * 64 + l16 * 4); ss += (v.x * v.x + v.y * v.y) + (v.z * v.z + v.w * v.w); }
#pragma unroll
    for (int i = 0; i < 2; i++) { const float4 v = ld4(c + 256 + i * 64 + l16 * 4); ss2 += (v.x * v.x + v.y * v.y) + (v.z * v.z + v.w * v.w); }
    ss = row16_sum(ss);
    ss2 = row16_sum(ss2);
    if (l16 == 0) {
      RSQ[t] = rsqrtf(ss * (1.f / 256.f) + NORM_EPS);
      RSKV[t] = rsqrtf(ss2 * (1.f / 128.f) + NORM_EPS);
    }
    {
      const float t1 = bf2f(c[384 + l16]), t2 = bf2f(c[400 + l16]);
      const float ang = (float)p.pos[t] * inv_freq;
      const float cs = cosf(ang), sn = sinf(ang);
      CS[t * 32 + l16] = cs;
      CS[t * 32 + 16 + l16] = sn;
      const u16 o1 = f2bf(t1 * cs - t2 * sn), o2 = f2bf(t2 * cs + t1 * sn);
#pragma unroll
      for (int hh = 0; hh < 8; hh++) {
        const size_t base = ((size_t)(b * 8 + hh) * SEQ + s) * 96 + 64;
        Kb[base + l16] = o1;
        Kb[base + 16 + l16] = o2;
      }
    }
  }
}

DI void kv_epilogue(f32x16 (&acc)[2][2], int m0, int hh, SmemGemm& sm, const float* __restrict__ RSKV, u16* __restrict__ Kb, u16* __restrict__ Vt) {
  const int lane = threadIdx.x & 63, w = threadIdx.x >> 6, wm = w >> 1, wn = w & 1, r = lane & 31, h = lane >> 5;
  float* wb = (float*)&sm + w * (64 * 68);
#pragma unroll
  for (int i = 0; i < 2; i++)
#pragma unroll
    for (int j = 0; j < 2; j++)
#pragma unroll
      for (int g = 0; g < 16; g++)
        wb[(i * 32 + (g & 3) + 8 * (g >> 2) + 4 * h) * 68 + j * 32 + r] = acc[i][j][g];
  __syncthreads();
  const int row0 = m0 + wm * 64, b = row0 >> 12, s0 = row0 & (SEQ - 1);
  if (wn == 0) {
    const int rl = lane >> 4, c4 = (lane & 15) * 4;
#pragma unroll 4
    for (int it = 0; it < 16; it++) {
      const int row_l = it * 4 + rl;
      float4 v = *(const float4*)&wb[row_l * 68 + c4];
      const float rs = RSKV[row0 + row_l];
      v.x *= rs; v.y *= rs; v.z *= rs; v.w *= rs;
      st4(Kb + ((size_t)(b * 8 + hh) * SEQ + s0 + row_l) * 96 + c4, v);
    }
  } else {
    u16* vp = Vt + ((size_t)(b * 8 + hh) * 64 + lane) * LDV + s0;
#pragma unroll 4
    for (int rg = 0; rg < 16; rg++) {
      const float4 rs = *(const float4*)(RSKV + row0 + rg * 4);
      float4 v;
      v.x = wb[(rg * 4 + 0) * 68 + lane] * rs.x; v.y = wb[(rg * 4 + 1) * 68 + lane] * rs.y;
      v.z = wb[(rg * 4 + 2) * 68 + lane] * rs.z; v.w = wb[(rg * 4 + 3) * 68 + lane] * rs.w;
      st4(vp + rg * 4, v);
    }
  }
}

DI void phase3(const Params& p, Smem& sm, int* cnt) {
  char* ws = p.ws;
  const u16* LA = (const u16*)((char*)p.out + D_LA);
  const u16* CQKV = (const u16*)(ws + O_CQKV);
  u16* NLW = (u16*)(ws + O_U);
  u16* Ab = (u16*)(ws + O_U + (size_t)T * 512 * 2);
  u16* Qb = (u16*)(ws + O_Q);
  u16* Kb = (u16*)(ws + O_K);
  u16* Vt = (u16*)((char*)p.out + D_VT);
  const float* RSQ = (const float*)(ws + O_RSQ);
  const float* RSKV = (const float*)(ws + O_RSKV);
  const float* CS = (const float*)(ws + O_CS);
  const float qscale = 1.4426950408889634f * 0.10206207261596575f;
  const int n_dec = 32 * 4, n_icl = 32 * 4, n_q = 32 * 6, n_kv = 32 * 8;
  const int xcd = blockIdx.x & 7, lb = blockIdx.x >> 3, nlb = gridDim.x >> 3;
  for (int li = lb; li < n_dec + n_icl + n_q + n_kv; li += nlb) {
    f32x16 acc[2][2];
    acc_zero(acc);
    if (li < n_dec) {
      const int mt = xcd * 32 + (li >> 2), nt = li & 3;
      gemm_tile_acc(LA, 128, (const u16*)(ws + O_WDEC), 64, 64, mt * 128, nt * 128, acc, sm.g);
      const float* w0 = p.w0;
      acc_epilogue(acc, mt * 128, nt * 128, sm.g, [&](int row, int col, float4 v) {
        const float4 ww = *(const float4*)(w0 + col);
        st4(NLW + (size_t)row * 512 + col, make_float4(1.f - __expf(-DECAY_SCALE * sigmoidf_(ww.x + v.x)), 1.f - __expf(-DECAY_SCALE * sigmoidf_(ww.y + v.y)),
                                                       1.f - __expf(-DECAY_SCALE * sigmoidf_(ww.z + v.z)), 1.f - __expf(-DECAY_SCALE * sigmoidf_(ww.w + v.w))));
      });
    } else if (li < n_dec + n_icl) {
      const int tt = li - n_dec, mt = xcd * 32 + (tt >> 2), nt = tt & 3;
      gemm_tile_acc(LA + 64, 128, (const u16*)(ws + O_WICL), 64, 64, mt * 128, nt * 128, acc, sm.g);
      const float* a0 = p.a0;
      acc_epilogue(acc, mt * 128, nt * 128, sm.g, [&](int row, int col, float4 v) {
        const float4 aa = *(const float4*)(a0 + col);
        st4(Ab + (size_t)row * 512 + col, sigm4(make_float4(aa.x + v.x, aa.y + v.y, aa.z + v.z, aa.w + v.w)));
      });
    } else if (li < n_dec + n_icl + n_q) {
      const int tt = li - n_dec - n_icl, ml = tt / 6, nt = tt - ml * 6, mt = xcd * 32 + ml;
      gemm_tile_acc(CQKV, CQW, (const u16*)(ws + O_WUQ), LDQW, 256, mt * 128, nt * 128, acc, sm.g);
      acc_epilogue(acc, mt * 128, nt * 128, sm.g, [&](int row, int col, float4 v) {
        const int hh = col / 96, d = col - hh * 96, b = row >> 12, s = row & (SEQ - 1);
        const float rs = RSQ[row] * qscale;
        v.x *= rs; v.y *= rs; v.z *= rs; v.w *= rs;
        float4 pv;
        {
          const bool up = (d < 80);
          const float ax = dpp_mov<0x104>(v.x), bx = dpp_mov<0x114>(v.x);
          const float ay = dpp_mov<0x104>(v.y), by = dpp_mov<0x114>(v.y);
          const float az = dpp_mov<0x104>(v.z), bz = dpp_mov<0x114>(v.z);
          const float aw = dpp_mov<0x104>(v.w), bw = dpp_mov<0x114>(v.w);
          pv.x = up ? ax : bx; pv.y = up ? ay : by; pv.z = up ? az : bz; pv.w = up ? aw : bw;
        }
        if (d >= 64) {
          const int i = (d - 64) & 15;
          const float4 cs = *(const float4*)(CS + (size_t)row * 32 + i);
          const float4 sn = *(const float4*)(CS + (size_t)row * 32 + 16 + i);
          const float sg = (d < 80) ? -1.f : 1.f;
          v.x = v.x * cs.x + sg * pv.x * sn.x; v.y = v.y * cs.y + sg * pv.y * sn.y;
          v.z = v.z * cs.z + sg * pv.z * sn.z; v.w = v.w * cs.w + sg * pv.w * sn.w;
        }
        st4(Qb + ((size_t)(b * 8 + hh) * SEQ + s) * 96 + d, v);
      });
    } else {
      const int tt = li - n_dec - n_icl - n_q, mt = xcd * 32 + (tt >> 3), nt = tt & 7;
      gemm_tile_acc(CQKV + 256, CQW, (const u16*)(ws + O_WUKV), 128, 128, mt * 128, nt * 128, acc, sm.g);
      kv_epilogue(acc, mt * 128, nt, sm.g, RSKV, Kb, Vt);
    }
  }
}

DI void scan_item(const Params& p, int item, SmemScan& sm) {
  const int tid = threadIdx.x, lane = tid & 63, w = tid >> 6;
  const int vg = item & 3, bh = item >> 2, hh = bh & 7, b = bh >> 3;
  char* ws = p.ws;
  const u16* FA = (const u16*)(ws + O_FA);
  const u16* NLW = (const u16*)(ws + O_U);
  const u16* Ab = (const u16*)(ws + O_U + (size_t)T * 512 * 2);
  float* BONUS = (float*)(ws + O_BONUS);
  u16* Y = (u16*)((char*)p.out + D_YA);
  const int st = tid >> 4, kq = tid & 15, col = hh * 64 + kq * 4;
  float mu_r[4], mu_k[4], mu_v[4], ckk[4], cka[4], crk[4], omc[4];
#pragma unroll
  for (int i = 0; i < 4; i++) {
    mu_r[i] = p.mu[col + i]; mu_k[i] = p.mu[512 + col + i]; mu_v[i] = p.mu[1024 + col + i];
    ckk[i] = p.k_k[col + i]; cka[i] = p.k_a[col + i]; crk[i] = p.r_k[col + i]; omc[i] = 1.f - cka[i];
  }
  struct SIn { uint2 rf, rp, kf, kp, vf, vp, a, w; };
  auto issue = [&](int tc, SIn& g) {
    const int s = tc + st;
    const size_t t = (size_t)b * SEQ + s;
    const u16* fa = FA + t * FAW + col;
    const u16* fp = (s > 0) ? fa - FAW : fa;
    g.rf = *(const uint2*)(fa);
    g.kf = *(const uint2*)(fa + 512);
    g.vf = *(const uint2*)(fa + 1024);
    g.rp = *(const uint2*)(fp);
    g.kp = *(const uint2*)(fp + 512);
    g.vp = *(const uint2*)(fp + 1024);
    g.a = *(const uint2*)(Ab + t * 512 + col);
    g.w = *(const uint2*)(NLW + t * 512 + col);
  };
  auto unp = [](uint2 u, float (&f)[4]) {
    f[0] = __uint_as_float(u.x << 16); f[1] = __uint_as_float(u.x & 0xffff0000u);
    f[2] = __uint_as_float(u.y << 16); f[3] = __uint_as_float(u.y & 0xffff0000u);
  };
  auto process = [&](int tc, const SIn& g, int pb) {
    float rf[4], rp[4], kf[4], kp[4], vf[4], vp[4], av[4], nl[4];
    unp(g.rf, rf); unp(g.rp, rp); unp(g.kf, kf); unp(g.kp, kp); unp(g.vf, vf); unp(g.vp, vp); unp(g.a, av); unp(g.w, nl);
    if (tc + st == 0) {
#pragma unroll
      for (int i = 0; i < 4; i++) { rp[i] = 0.f; kp[i] = 0.f; vp[i] = 0.f; }
    }
    float rr[4], ks[4], vs[4], kkr[4];
    float n2 = 0.f, bon = 0.f;
#pragma unroll
    for (int i = 0; i < 4; i++) {
      rr[i] = rf[i] + mu_r[i] * (rp[i] - rf[i]);
      ks[i] = kf[i] + mu_k[i] * (kp[i] - kf[i]);
      vs[i] = vf[i] + mu_v[i] * (vp[i] - vf[i]);
      kkr[i] = ks[i] * ckk[i];
      n2 += kkr[i] * kkr[i];
    }
    n2 = row16_sum(n2);
    const float inv = __builtin_amdgcn_rsqf(fmaxf(n2, 1e-24f));
    float4 o_w, o_kk, o_b, o_kx, o_r;
    float kx[4], kk[4];
#pragma unroll
    for (int i = 0; i < 4; i++) {
      kk[i] = kkr[i] * inv;
      kx[i] = ks[i] * (av[i] * cka[i] + omc[i]);
      bon += rr[i] * kx[i] * crk[i];
    }
    bon = row16_sum(bon);
    o_w = make_float4(1.f - nl[0], 1.f - nl[1], 1.f - nl[2], 1.f - nl[3]);
    o_kk = make_float4(kk[0], kk[1], kk[2], kk[3]);
    o_b = make_float4(kk[0] * av[0], kk[1] * av[1], kk[2] * av[2], kk[3] * av[3]);
    o_kx = make_float4(kx[0], kx[1], kx[2], kx[3]);
    o_r = make_float4(rr[0], rr[1], rr[2], rr[3]);
    *(float4*)&sm.vec[pb][st][0][kq * 4] = o_w;
    *(float4*)&sm.vec[pb][st][1][kq * 4] = o_kk;
    *(float4*)&sm.vec[pb][st][2][kq * 4] = o_b;
    *(float4*)&sm.vec[pb][st][3][kq * 4] = o_kx;
    *(float4*)&sm.vec[pb][st][4][kq * 4] = o_r;
    if ((kq >> 2) == vg) *(float4*)&sm.v[pb][st][(kq & 3) * 4] = make_float4(vs[0], vs[1], vs[2], vs[3]);
    if (vg == 0 && kq == 0) BONUS[((size_t)b * SEQ + tc + st) * 8 + hh] = bon;
  };
  const int vl = lane >> 4, kg = lane & 15;
  const int rowb = w * 4 + vl;
  f32x2 S01 = {0.f, 0.f}, S23 = {0.f, 0.f};
  const int ys = lane >> 2, yr = w * 4 + (lane & 3);
  SIn gA, gB;
  issue(0, gA);
  issue(16, gB);
  __syncthreads();
  process(0, gA, 0);
  __syncthreads();
#define LO2(v) (f32x2{(v).x, (v).y})
#define HI2(v) (f32x2{(v).z, (v).w})
#define SCAN_CHUNK(tc_, gfree, gnext, cb) do { \
    process(((tc_) + 16 < SEQ) ? (tc_) + 16 : SEQ - 16, gnext, (cb) ^ 1); \
    issue(((tc_) + 32 < SEQ) ? (tc_) + 32 : SEQ - 16, gfree); \
    float4 w4 = *(const float4*)&sm.vec[cb][0][0][kg * 4]; \
    float4 kk4 = *(const float4*)&sm.vec[cb][0][1][kg * 4]; \
    float4 b4 = *(const float4*)&sm.vec[cb][0][2][kg * 4]; \
    float4 kx4 = *(const float4*)&sm.vec[cb][0][3][kg * 4]; \
    float4 r4 = *(const float4*)&sm.vec[cb][0][4][kg * 4]; \
    float vv = sm.v[cb][0][rowb]; \
    _Pragma("unroll") for (int s = 0; s < 16; s++) { \
      const int sn = (s < 15) ? s + 1 : 15; \
      const float4 nw4 = *(const float4*)&sm.vec[cb][sn][0][kg * 4]; \
      const float4 nkk4 = *(const float4*)&sm.vec[cb][sn][1][kg * 4]; \
      const float4 nb4 = *(const float4*)&sm.vec[cb][sn][2][kg * 4]; \
      const float4 nkx4 = *(const float4*)&sm.vec[cb][sn][3][kg * 4]; \
      const float4 nr4 = *(const float4*)&sm.vec[cb][sn][4][kg * 4]; \
      const float nvv = sm.v[cb][sn][rowb]; \
      const f32x2 d2 = S23 * HI2(kk4) + S01 * LO2(kk4); \
      const f32x2 vv2 = {vv, vv}; \
      const f32x2 t01 = vv2 * LO2(kx4) + S01 * LO2(w4); \
      const f32x2 t23 = vv2 * HI2(kx4) + S23 * HI2(w4); \
      const float d = row16_sum(d2.x + d2.y); \
      const f32x2 dd = {d, d}; \
      S01 = t01 - dd * LO2(b4); \
      S23 = t23 - dd * HI2(b4); \
      const f32x2 y2 = S23 * HI2(r4) + S01 * LO2(r4); \
      sm.yp[s][rowb][kg] = y2.x + y2.y; \
      w4 = nw4; kk4 = nkk4; b4 = nb4; kx4 = nkx4; r4 = nr4; vv = nvv; \
    } \
    {     \
      const float4 p0 = *(const float4*)&sm.yp[ys][yr][0], p1 = *(const float4*)&sm.yp[ys][yr][4]; \
      const float4 p2 = *(const float4*)&sm.yp[ys][yr][8], p3 = *(const float4*)&sm.yp[ys][yr][12]; \
      const float y = ((p0.x + p0.y) + (p0.z + p0.w)) + ((p1.x + p1.y) + (p1.z + p1.w)) + ((p2.x + p2.y) + (p2.z + p2.w)) + ((p3.x + p3.y) + (p3.z + p3.w)); \
      Y[((size_t)b * SEQ + (tc_) + ys) * LDY + hh * 64 + vg * 16 + yr] = f2bf(y); \
    } \
    __syncthreads(); } while (0)
#pragma unroll 1
  for (int tc = 0; tc < SEQ; tc += 32) {
    SCAN_CHUNK(tc, gA, gB, 0);
    SCAN_CHUNK(tc + 16, gB, gA, 1);
  }
  __syncthreads();
}

DI void attn_item(const Params& p, int bh, int qb, SmemAttn& sm) {
  const int tid = threadIdx.x, lane = tid & 63, w = tid >> 6, r = lane & 31, h = lane >> 5;
  char* ws = p.ws;
  const u16* Qb = (const u16*)(ws + O_Q) + (size_t)bh * SEQ * 96;
  const u16* Kb = (const u16*)(ws + O_K) + (size_t)bh * SEQ * 96;
  const u16* Vt = (const u16*)((char*)p.out + D_VT) + (size_t)bh * 64 * LDV;
  const u16* SZB = (const u16*)(ws + O_SZB);
  u16* O = (u16*)((char*)p.out + D_O);
  const int b = bh >> 3, hh = bh & 7;
  const int q0 = qb * 128;
  const int qw = q0 + w * 32;
  const int qg = qw + r;
#if NAIVE_ATTN
  if (h == 0) {
    float m = -1e30f, l = 0.f;
    const size_t t = (size_t)b * SEQ + qg;
    for (int dc = 0; dc < 64; dc += 16) {
      float o[16];
      m = -1e30f; l = 0.f;
#pragma unroll
      for (int d = 0; d < 16; d++) o[d] = 0.f;
      for (int key = 0; key <= qg; key++) {
        float s = 0.f;
        for (int d = 0; d < 96; d++) s += bf2f(Qb[(size_t)qg * 96 + d]) * bf2f(Kb[(size_t)key * 96 + d]);
        float mn = fmaxf(m, s);
        float al = exp2f(m - mn), pp = exp2f(s - mn);
        l = l * al + pp;
#pragma unroll
        for (int d = 0; d < 16; d++) o[d] = o[d] * al + pp * bf2f(Vt[(size_t)(dc + d) * LDV + key]);
        m = mn;
      }
#pragma unroll
      for (int d = 0; d < 16; d++) O[t * LDY + hh * 64 + dc + d] = f2bf(o[d] / l * bf2f(SZB[t * 512 + hh * 64 + dc + d]));
    }
  }
#else
  bf16x8 bq[6];
#pragma unroll
  for (int s = 0; s < 6; s++) bq[s] = *(const bf16x8*)(Qb + (size_t)qg * 96 + s * 16 + h * 8);
  const f32x16 zero16 = {0.f, 0.f, 0.f, 0.f, 0.f, 0.f, 0.f, 0.f, 0.f, 0.f, 0.f, 0.f, 0.f, 0.f, 0.f, 0.f};
  f32x16 oacc[2];
#pragma unroll
  for (int g = 0; g < 16; g++) { oacc[0][g] = 0.f; oacc[1][g] = 0.f; }
  float m_run = -1e30f, l_run = 0.f;
  const int nkt = (q0 + 128) >> 6;
  u32x4 RK0, RK1, RK2, RV0, RV1;
  const int kr0 = tid / 12, kc0 = tid - kr0 * 12;
  const int kr1 = (tid + 256) / 12, kc1 = (tid + 256) - kr1 * 12;
  const int kr2 = (tid + 512) / 12, kc2 = (tid + 512) - kr2 * 12;
  const int vr0 = tid >> 3, vc0 = tid & 7;
#define ATT_KISSUE(kt_) do { const int k0_ = (((kt_) < nkt) ? (kt_) : nkt - 1) << 6; \
    RK0 = *(const u32x4*)(Kb + (size_t)(k0_ + kr0) * 96 + kc0 * 8); \
    RK1 = *(const u32x4*)(Kb + (size_t)(k0_ + kr1) * 96 + kc1 * 8); \
    RK2 = *(const u32x4*)(Kb + (size_t)(k0_ + kr2) * 96 + kc2 * 8); } while (0)
#define ATT_VISSUE(kt_) do { const int k0_ = (((kt_) < nkt) ? (kt_) : nkt - 1) << 6; \
    RV0 = *(const u32x4*)(Vt + (size_t)vr0 * LDV + k0_ + vc0 * 8); \
    RV1 = *(const u32x4*)(Vt + (size_t)(vr0 + 32) * LDV + k0_ + vc0 * 8); } while (0)
#define ATT_KSTASH(buf) do { \
    *(u32x4*)&sm.k[buf][kr0][kc0 * 8] = RK0; *(u32x4*)&sm.k[buf][kr1][kc1 * 8] = RK1; *(u32x4*)&sm.k[buf][kr2][kc2 * 8] = RK2; } while (0)
#define ATT_VSTASH(buf) do { \
    *(u32x4*)&sm.vt[buf][vr0][vc0 * 8] = RV0; *(u32x4*)&sm.vt[buf][vr0 + 32][vc0 * 8] = RV1; } while (0)
#define ATT_S(SD, buf) do { \
      _Pragma("unroll") for (int kb = 0; kb < 2; kb++) { \
        { const bf16x8 kf0 = *(const bf16x8*)&sm.k[buf][kb * 32 + r][h * 8]; \
          SD[kb] = __builtin_amdgcn_mfma_f32_32x32x16_bf16(kf0, bq[0], zero16, 0, 0, 0); } \
        _Pragma("unroll") for (int s = 1; s < 6; s++) { \
          const bf16x8 kf = *(const bf16x8*)&sm.k[buf][kb * 32 + r][s * 16 + h * 8]; \
          SD[kb] = __builtin_amdgcn_mfma_f32_32x32x16_bf16(kf, bq[s], SD[kb], 0, 0, 0); \
        } \
      } } while (0)
#define ATT_SMPV(sacc, kt, buf) do { \
      const int k0 = (kt) << 6; \
      if (k0 + 63 > qw) { \
        _Pragma("unroll") for (int kb = 0; kb < 2; kb++) \
          _Pragma("unroll") for (int g = 0; g < 16; g++) { \
            const int key = k0 + kb * 32 + (g & 3) + 8 * (g >> 2) + 4 * h; \
            if (key > qg) sacc[kb][g] = -1e30f; \
          } \
      } \
      float mloc = -1e30f; \
      _Pragma("unroll") for (int kb = 0; kb < 2; kb++) \
        _Pragma("unroll") for (int g = 0; g < 16; g++) mloc = fmaxf(mloc, sacc[kb][g]); \
      mloc = fmaxf(mloc, __shfl_xor(mloc, 32, 64)); \
      const float m_new = fmaxf(m_run, mloc); \
      if (__any(m_new > m_run)) { \
        const float alpha = __builtin_amdgcn_exp2f(m_run - m_new); \
        l_run *= alpha; \
        _Pragma("unroll") for (int g = 0; g < 16; g++) { oacc[0][g] *= alpha; oacc[1][g] *= alpha; } \
        m_run = m_new; \
      } \
      float psum = 0.f; \
      _Pragma("unroll") for (int kb = 0; kb < 2; kb++) \
        _Pragma("unroll") for (int g = 0; g < 16; g++) { \
          const float pv = __builtin_amdgcn_exp2f(sacc[kb][g] - m_run); \
          sacc[kb][g] = pv; \
          psum += pv; \
        } \
      l_run += psum; \
      _Pragma("unroll") for (int kb = 0; kb < 2; kb++) \
        _Pragma("unroll") for (int sp = 0; sp < 2; sp++) { \
          uint4 pk; \
          pk.x = pack2(sacc[kb][8 * sp + 0], sacc[kb][8 * sp + 1]); \
          pk.y = pack2(sacc[kb][8 * sp + 2], sacc[kb][8 * sp + 3]); \
          pk.z = pack2(sacc[kb][8 * sp + 4], sacc[kb][8 * sp + 5]); \
          pk.w = pack2(sacc[kb][8 * sp + 6], sacc[kb][8 * sp + 7]); \
          const bf16x8 pf = __builtin_bit_cast(bf16x8, pk); \
          _Pragma("unroll") for (int db = 0; db < 2; db++) { \
            const s16x4 lo = *(const s16x4*)&sm.vt[buf][db * 32 + r][kb * 32 + 16 * sp + 4 * h]; \
            const s16x4 hi = *(const s16x4*)&sm.vt[buf][db * 32 + r][kb * 32 + 16 * sp + 8 + 4 * h]; \
            const bf16x8 vf = __builtin_shufflevector(lo, hi, 0, 1, 2, 3, 4, 5, 6, 7); \
            oacc[db] = __builtin_amdgcn_mfma_f32_32x32x16_bf16(vf, pf, oacc[db], 0, 0, 0); \
          } \
        } \
    } while (0)
#define ATT_ITER(kt, SC, SN, par) do { \
    ATT_KSTASH((par) ^ 1); \
    ATT_VSTASH(par); \
    __syncthreads(); \
    ATT_KISSUE((kt) + 2); \
    ATT_VISSUE((kt) + 1); \
    if ((kt) + 1 < nkt && (((kt) + 1) << 6) <= qw + 31) ATT_S(SN, (par) ^ 1); \
    if (((kt) << 6) <= qw + 31) ATT_SMPV(SC, kt, par); \
  } while (0)
  f32x16 SA[2], SB[2];
  ATT_KISSUE(0);
  __syncthreads();
  ATT_KSTASH(0);
  __syncthreads();
  ATT_KISSUE(1);
  ATT_VISSUE(0);
  ATT_S(SA, 0);
#pragma unroll 1
  for (int kt = 0; kt < nkt; kt += 2) {
    ATT_ITER(kt, SA, SB, 0);
    ATT_ITER(kt + 1, SB, SA, 1);
  }
  const float l_tot = l_run + __shfl_xor(l_run, 32, 64);
  const float inv_l = 1.f / l_tot;
  const size_t t = (size_t)b * SEQ + qg;
#pragma unroll
  for (int db = 0; db < 2; db++)
#pragma unroll
    for (int gq = 0; gq < 4; gq++) {
      const int d = db * 32 + 8 * gq + 4 * h;
      const uint2 z = *(const uint2*)(SZB + t * 512 + hh * 64 + d);
      const float z0 = __uint_as_float(z.x << 16), z1 = __uint_as_float(z.x & 0xffff0000u);
      const float z2 = __uint_as_float(z.y << 16), z3 = __uint_as_float(z.y & 0xffff0000u);
      uint2 o;
      o.x = pack2(oacc[db][4 * gq + 0] * inv_l * z0, oacc[db][4 * gq + 1] * inv_l * z1);
      o.y = pack2(oacc[db][4 * gq + 2] * inv_l * z2, oacc[db][4 * gq + 3] * inv_l * z3);
      *(uint2*)(O + t * LDY + hh * 64 + d) = o;
    }
#endif
}

DI void phase4(const Params& p, Smem& sm, int* cnt, int mode = 0) {
  __shared__ int s_v;
  const unsigned xcc = xcc_id();
  if (threadIdx.x == 0) s_v = atomicExch(&cnt[64 + xcc * 256 + cu_key()], 1);
  __syncthreads();
  const bool scan_first = (s_v == 0);
  __syncthreads();
  if (scan_first && mode != 2) {
    if (threadIdx.x == 0) s_v = atomicAdd(&cnt[8], 1);
    __syncthreads();
    const int item = s_v;
    __syncthreads();
    if (item < 256) {
      __builtin_amdgcn_s_setprio(3);
      scan_item(p, item, sm.sc);
      __builtin_amdgcn_s_setprio(0);
    }
  }
  QState qs; qs.q = (int)xcc; qs.tried = 0;
  if (mode != 1) for (;;) {
    const int li = fetch_item(cnt, 256, qs);
    if (li < 0) break;
    attn_item(p, qs.q * 8 + (li >> 5), 31 - (li & 31), sm.at);
  }
  if (mode != 2) for (;;) {
    __syncthreads();
    if (threadIdx.x == 0) s_v = atomicAdd(&cnt[8], 1);
    __syncthreads();
    const int item = s_v;
    if (item >= 256) break;
    scan_item(p, item, sm.sc);
  }
}

DI void phase5(const Params& p) {
  const long gtid = (long)blockIdx.x * 256 + threadIdx.x, nth = (long)gridDim.x * 256;
  const int lane = threadIdx.x & 63, sub = lane >> 4, l16 = lane & 15;
  const long wave = gtid >> 6, nw = nth >> 6;
  char* ws = p.ws;
  const u16* FA = (const u16*)(ws + O_FA);
  const u16* SZA = (const u16*)(ws + O_SZA);
  const float* BONUS = (const float*)(ws + O_BONUS);
  u16* Y = (u16*)((char*)p.out + D_YA);
  for (long it = wave; it < (long)T * 2; it += nw) {
    const long item = it * 4 + sub;
    const long t = item >> 3;
    const int hh = (int)(item & 7), c = hh * 64 + l16 * 4;
    const int s = (int)(t & (SEQ - 1));
    const float4 y = ld4(Y + t * LDY + c);
    const float mean = row16_sum((y.x + y.y) + (y.z + y.w)) * (1.f / 64.f);
    const float d0 = y.x - mean, d1 = y.y - mean, d2 = y.z - mean, d3 = y.w - mean;
    const float var = row16_sum((d0 * d0 + d1 * d1) + (d2 * d2 + d3 * d3)) * (1.f / 64.f);
    const float rstd = rsqrtf(var + GN_EPS);
    const float4 gg = *(const float4*)(p.gn_g + c), gb = *(const float4*)(p.gn_b + c), mu = *(const float4*)(p.mu + 1024 + c);
    const float4 vf = ld4(FA + t * FAW + 1024 + c);
    float4 vp = ld4(FA + (s > 0 ? t - 1 : t) * FAW + 1024 + c);
    if (s == 0) vp = make_float4(0.f, 0.f, 0.f, 0.f);
    const float bon = BONUS[t * 8 + hh];
    const float4 z = ld4(SZA + t * 512 + c);
    float4 o;
    o.x = (d0 * rstd * gg.x + gb.x + bon * (vf.x + mu.x * (vp.x - vf.x))) * z.x;
    o.y = (d1 * rstd * gg.y + gb.y + bon * (vf.y + mu.y * (vp.y - vf.y))) * z.y;
    o.z = (d2 * rstd * gg.z + gb.z + bon * (vf.z + mu.z * (vp.z - vf.z))) * z.z;
    o.w = (d3 * rstd * gg.w + gb.w + bon * (vf.w + mu.w * (vp.w - vf.w))) * z.w;
    st4(Y + t * LDY + c, o);
  }
}

DI void phase6(const Params& p, Smem& sm, int* cnt) {
  char* ws = p.ws;
  const u16* YA = (const u16*)((char*)p.out + D_YA);
  const u16* O = (const u16*)((char*)p.out + D_O);
  const u16* G = (const u16*)(ws + O_G);
  u16* MG = (u16*)(ws + O_U);
  const int xcd = blockIdx.x & 7, lb = blockIdx.x >> 3, nlb = gridDim.x >> 3;
  for (int li = lb; li < 256; li += nlb) {
    const int mt = xcd * 32 + (li >> 3), nt = li & 7;
    f32x16 acc[2][2];
    acc_zero(acc);
    u32 pk1[2][2][8];
    gemm_tile_dual(YA, (const u16*)(ws + O_WOA), O, (const u16*)(ws + O_WOB), LDY, LDY, mt * 128, nt * 128, acc, pk1, sm.g);
    acc_epilogue2(pk1, acc, mt * 128, nt * 128, sm.g, [&](int row, int col, float4 va, float4 vb) {
      const float4 ga = ld4(G + (size_t)row * LDG + col);
      const float4 gb = ld4(G + (size_t)row * LDG + 1024 + col);
      st4(MG + (size_t)row * LDU + col, make_float4(va.x * ga.x + vb.x * gb.x, va.y * ga.y + vb.y * gb.y,
                                                   va.z * ga.z + vb.z * gb.z, va.w * ga.w + vb.w * gb.w));
    });
  }
}

DI void phase7(const Params& p, Smem& sm, int* cnt) {
  char* ws = p.ws;
  const u16* MG = (const u16*)(ws + O_U);
  u16* TP = (u16*)(ws + O_FA);
  const int xcd = blockIdx.x & 7, lb = blockIdx.x >> 3, nlb = gridDim.x >> 3;
  for (int li = lb; li < 256; li += nlb) {
    const int mt = xcd * 32 + (li >> 3), nt = li & 7;
    f32x16 acc[2][2];
    acc_zero(acc);
    gemm_tile_acc(MG, LDU, (const u16*)(ws + O_WO), LDU, 1024, mt * 128, nt * 128, acc, sm.g);
    acc_epilogue(acc, mt * 128, nt * 128, sm.g, [&](int row, int col, float4 v) { st4(TP + (size_t)row * LDU + col, v); });
  }
}

DI void phase8(const Params& p) {
  int bz;
  asm volatile("v_mov_b32 %0, 0" : "=v"(bz));
  const long gtid = (long)(blockIdx.x + bz) * 256 + threadIdx.x, nth = (long)gridDim.x * 256;
  const int lane = threadIdx.x & 63;
  const long wave = gtid >> 6, nw = nth >> 6;
  const u16* TP = (const u16*)(p.ws + O_FA);
  for (long row = wave; row < T; row += nw) {
    float v[16];
    float ss = 0.f;
#pragma unroll
    for (int i = 0; i < 2; i++) {
      const uint4 u = *(const uint4*)(TP + row * LDU + i * 512 + lane * 8);
      v[i * 8 + 0] = __uint_as_float(u.x << 16); v[i * 8 + 1] = __uint_as_float(u.x & 0xffff0000u);
      v[i * 8 + 2] = __uint_as_float(u.y << 16); v[i * 8 + 3] = __uint_as_float(u.y & 0xffff0000u);
      v[i * 8 + 4] = __uint_as_float(u.z << 16); v[i * 8 + 5] = __uint_as_float(u.z & 0xffff0000u);
      v[i * 8 + 6] = __uint_as_float(u.w << 16); v[i * 8 + 7] = __uint_as_float(u.w & 0xffff0000u);
    }
#pragma unroll
    for (int i = 0; i < 16; i++) ss += v[i] * v[i];
    ss = wave_sum(ss);
    const float rs = rsqrtf(ss * (1.f / 1024.f) + NORM_EPS);
#pragma unroll
    for (int i = 0; i < 4; i++) {
      const int c = (i >> 1) * 512 + lane * 8 + (i & 1) * 4;
      const float4 g = *(const float4*)(p.g_post + c);
      const float4 xx = *(const float4*)(p.x + row * 1024 + c);
      float4 o;
      o.x = xx.x + v[i * 4 + 0] * rs * g.x; o.y = xx.y + v[i * 4 + 1] * rs * g.y;
      o.z = xx.z + v[i * 4 + 2] * rs * g.z; o.w = xx.w + v[i * 4 + 3] * rs * g.w;
      *(float4*)(p.out + row * 1024 + c) = o;
    }
  }
}

__global__ void __launch_bounds__(256, 2) fwd_megakernel(Params p) {
  cg::grid_group grid = cg::this_grid();
  __shared__ Smem sm;
  int* cnt = (int*)(p.ws + O_CNT);
  GBar gb;
  gbar_init(gb, (unsigned*)(p.ws + O_CNT) + 12288);
  if (p.never) grid.sync();
#define GSYNC() gbar_sync(gb)
  phase0(p);
  GSYNC();
  if (PROBE == 0) { phase0(p); GSYNC(); }
  phase1(p, sm, cnt);
  GSYNC();
  if (PROBE == 1) { phase1(p, sm, cnt + 4096); GSYNC(); }
  phase2(p);
  GSYNC();
  if (PROBE == 2) { phase2(p); GSYNC(); }
  phase3(p, sm, cnt + 8);
  GSYNC();
  if (PROBE == 3) { phase3(p, sm, cnt + 4096); GSYNC(); }
  if (PROBE == 41) { phase4(p, sm, cnt + 4096, 1); GSYNC(); }
  if (PROBE == 42) { phase4(p, sm, cnt + 4096, 2); GSYNC(); }
  phase4(p, sm, cnt + 1024);
  GSYNC();
  if (PROBE == 4) { phase4(p, sm, cnt + 4096); GSYNC(); }
  phase5(p);
  GSYNC();
  phase6(p, sm, cnt + 16);
  GSYNC();
  if (PROBE == 6) { phase6(p, sm, cnt + 4096); GSYNC(); }
  phase7(p, sm, cnt + 24);
  GSYNC();
  if (PROBE == 7) { phase7(p, sm, cnt + 4096); GSYNC(); }
  if (PROBE == 80) { for (int rep = 0; rep < 8; rep++) GSYNC(); }
  phase8(p);
}

extern "C" void kernel_launch(void* const* d_in, const int* in_sizes, int n_in,
                              void* d_out, int out_size, void* d_ws, size_t ws_size,
                              hipStream_t stream) {
  static int grid_blocks = 0;
  if (!grid_blocks) {
    int dev = 0, cus = 0, per_cu = 0;
    hipGetDevice(&dev);
    hipDeviceGetAttribute(&cus, hipDeviceAttributeMultiprocessorCount, dev);
    hipOccupancyMaxActiveBlocksPerMultiprocessor(&per_cu, fwd_megakernel, 256, 0);
    if (per_cu > 2) per_cu = 2;
    if (per_cu < 1) per_cu = 1;
    grid_blocks = cus * per_cu;
  }
  if (ws_size < WS_NEED) { fprintf(stderr, "workspace too small: %zu < %zu\n", ws_size, (size_t)WS_NEED); return; }
  Params p{};
  p.x = (const float*)d_in[0]; p.pos = (const int*)d_in[1]; p.g_pre = (const float*)d_in[2]; p.w_in = (const float*)d_in[3];
  p.b_gate = (const float*)d_in[4]; p.mu = (const float*)d_in[5]; p.w0 = (const float*)d_in[6]; p.w_dec = (const float*)d_in[7];
  p.a0 = (const float*)d_in[8]; p.w_icl = (const float*)d_in[9]; p.k_k = (const float*)d_in[10]; p.k_a = (const float*)d_in[11];
  p.r_k = (const float*)d_in[12]; p.gn_g = (const float*)d_in[13]; p.gn_b = (const float*)d_in[14]; p.w_oa = (const float*)d_in[15];
  p.g_q = (const float*)d_in[16]; p.w_uq = (const float*)d_in[17]; p.g_kv = (const float*)d_in[18]; p.w_ukv = (const float*)d_in[19];
  p.w_ob = (const float*)d_in[20]; p.w_o = (const float*)d_in[21]; p.g_post = (const float*)d_in[22];
  p.out = (float*)d_out; p.ws = (char*)d_ws;
  p.never = 0;
  (void)hipMemsetAsync((char*)d_ws + O_CNT, 0, 65536, stream);
  void* args[] = {&p};
  hipError_t e = hipLaunchCooperativeKernel((void*)fwd_megakernel, dim3(grid_blocks), dim3(256), args, 0, stream);
  if (e != hipSuccess) fprintf(stderr, "cooperative launch failed: %s (grid %d)\n", hipGetErrorString(e), grid_blocks);
}
```

```cpp
#include <hip/hip_runtime.h>
#include <hip/hip_cooperative_groups.h>
#include <cstdio>
namespace cg = cooperative_groups;

#ifndef PROBE
#define PROBE -1
#endif
#ifndef NAIVE_GEMM
#define NAIVE_GEMM 0
#endif
#ifndef NAIVE_ATTN
#define NAIVE_ATTN 0
#endif

typedef unsigned short u16;
typedef unsigned int u32;
typedef __attribute__((ext_vector_type(8))) short bf16x8;
typedef __attribute__((ext_vector_type(4))) short s16x4;
typedef __attribute__((ext_vector_type(16))) float f32x16;
#define DI __device__ __forceinline__

constexpr int T = 32768, SEQ = 4096, NB = 8, DM = 1024;
constexpr int INC = 5152, INP = 5248;
constexpr int FAW = 1664;
constexpr int C_ZA = 1664, C_CQ = 2176, C_ZB = 2592, C_G = 3104;
constexpr int LDU = 1088, LDY = 576, LDG = 2112, LDV = 4160, LDQW = 320;
constexpr int CQW = 416;
constexpr float DECAY_SCALE = 0.6065306597f;
constexpr float GN_EPS = 64e-5f;
constexpr float NORM_EPS = 1e-6f;

constexpr size_t O_WIN = 0;
constexpr size_t O_WUQ = O_WIN + (size_t)INP * LDU * 2;
constexpr size_t O_WUKV = O_WUQ + 768 * LDQW * 2;
constexpr size_t O_WOA = O_WUKV + 1024 * 128 * 2;
constexpr size_t O_WOB = O_WOA + 1024 * LDY * 2;
constexpr size_t O_WO = O_WOB + 1024 * LDY * 2;
constexpr size_t O_WDEC = O_WO + 1024 * LDU * 2;
constexpr size_t O_WICL = O_WDEC + 512 * 64 * 2;
constexpr size_t O_RSQ = O_WICL + 512 * 64 * 2;
constexpr size_t O_RSKV = O_RSQ + (size_t)T * 4;
constexpr size_t O_BONUS = O_RSKV + (size_t)T * 4;
constexpr size_t O_CS = O_BONUS + (size_t)T * 8 * 4;
constexpr size_t O_CNT = O_CS + (size_t)T * 32 * 4;
constexpr size_t O_U = O_CNT + 65536;
constexpr size_t O_FA = O_U + (size_t)T * LDU * 2;
constexpr size_t O_SZA = O_FA + (size_t)T * FAW * 2;
constexpr size_t O_SZB = O_SZA + (size_t)T * 512 * 2;
constexpr size_t O_CQKV = O_SZB + (size_t)T * 512 * 2;
constexpr size_t O_G = O_CQKV + (size_t)T * CQW * 2;
constexpr size_t O_Q = O_G + (size_t)T * LDG * 2;
constexpr size_t O_K = O_Q + (size_t)T * 768 * 2;
constexpr size_t WS_NEED = O_K + (size_t)T * 768 * 2;
static_assert(WS_NEED <= (size_t)536870912, "workspace budget");
constexpr size_t D_YA = 0;
constexpr size_t D_O = D_YA + (size_t)T * LDY * 2;
constexpr size_t D_VT = D_O + (size_t)T * LDY * 2;
constexpr size_t D_LA = D_VT + (size_t)64 * 64 * LDV * 2;
static_assert(D_LA + (size_t)T * 128 * 2 <= (size_t)T * 1024 * 4, "d_out scratch budget");

struct Params {
  const float* x; const int* pos; const float* g_pre; const float* w_in; const float* b_gate; const float* mu;
  const float* w0; const float* w_dec; const float* a0; const float* w_icl; const float* k_k; const float* k_a;
  const float* r_k; const float* gn_g; const float* gn_b; const float* w_oa; const float* g_q; const float* w_uq;
  const float* g_kv; const float* w_ukv; const float* w_ob; const float* w_o; const float* g_post;
  float* out; char* ws; long never;
};

DI u16 f2bf(float x) { u32 u = __float_as_uint(x); u += 0x7fffu + ((u >> 16) & 1u); return (u16)(u >> 16); }
DI float bf2f(u16 b) { return __uint_as_float(((u32)b) << 16); }
typedef __attribute__((ext_vector_type(2))) float f32x2;
typedef __attribute__((ext_vector_type(2))) __bf16 bf16x2_t;
DI u32 pack2(float a, float b) { f32x2 v = {a, b}; bf16x2_t q = __builtin_convertvector(v, bf16x2_t); return __builtin_bit_cast(u32, q); }
DI void st4(u16* p, float4 v) { uint2 o; o.x = pack2(v.x, v.y); o.y = pack2(v.z, v.w); *(uint2*)p = o; }
DI float4 ld4(const u16* p) { const uint2 u = *(const uint2*)p; return make_float4(__uint_as_float(u.x << 16), __uint_as_float(u.x & 0xffff0000u), __uint_as_float(u.y << 16), __uint_as_float(u.y & 0xffff0000u)); }
DI float sigmoidf_(float x) { return __builtin_amdgcn_rcpf(1.f + __expf(-x)); }
DI float siluf_(float x) { return x * __builtin_amdgcn_rcpf(1.f + __expf(-x)); }
DI float wave_sum(float v) {
#pragma unroll
  for (int o = 32; o > 0; o >>= 1) v += __shfl_xor(v, o, 64);
  return v;
}
template <int CTRL> DI float dpp_mov(float x) {
  return __builtin_bit_cast(float, __builtin_amdgcn_update_dpp(0, __builtin_bit_cast(int, x), CTRL, 0xf, 0xf, true));
}
DI float row16_sum(float x) {
  x += dpp_mov<0xB1>(x);
  x += dpp_mov<0x4E>(x);
  x += dpp_mov<0x141>(x);
  x += dpp_mov<0x140>(x);
  return x;
}


DI unsigned xcc_id() { return (unsigned)__builtin_amdgcn_s_getreg((3 << 11) | 20) & 0x7u; }
DI unsigned cu_key() { return ((unsigned)__builtin_amdgcn_s_getreg(63492) >> 8) & 0xffu; }
struct QState { int q, tried; };
DI int fetch_item(int* cnt, int per_q, QState& st) {
  __shared__ int s_q, s_tr, s_it;
  __syncthreads();
  if (threadIdx.x == 0) {
    int qq = st.q, tr = st.tried, it = -1;
    while (tr < 8) {
      it = atomicAdd(&cnt[qq], 1);
      if (it < per_q) break;
      it = -1; qq = (qq + 1) & 7; tr++;
    }
    s_q = qq; s_tr = tr; s_it = it;
  }
  __syncthreads();
  st.q = s_q; st.tried = s_tr;
  return s_it;
}


#define XB_XCNT(j) (64 * (j))
#define XB_XSUB(j) (512 + 64 * (j))
#define XB_XGEN(j) (1024 + 64 * (j))
#define XB_TOP 1536
#define XB_TOPGEN 1600
DI unsigned xb_ld(unsigned* p) { return __hip_atomic_load(p, __ATOMIC_RELAXED, __HIP_MEMORY_SCOPE_AGENT); }
DI unsigned xb_add(unsigned* p, unsigned v) { return __hip_atomic_fetch_add(p, v, __ATOMIC_RELAXED, __HIP_MEMORY_SCOPE_AGENT); }
struct GBar { unsigned* bar; unsigned x, nloc, nx; };
DI void gbar_init(GBar& g, unsigned* bar) {
  g.bar = bar; g.x = xcc_id(); g.nloc = 0; g.nx = 0;
  if (threadIdx.x == 0) (void)xb_add(&bar[XB_XCNT(g.x)], 1u);
}
DI void gbar_sync(GBar& g) {
  asm volatile("s_waitcnt vmcnt(0)" ::: "memory");
  __syncthreads();
  if (threadIdx.x == 0) {
    unsigned* bar = g.bar;
    if (g.nloc == 0u) {
      unsigned sum, cnt, mine;
      for (;;) {
        sum = 0u; cnt = 0u; mine = 0u;
#pragma unroll
        for (unsigned j = 0; j < 8; ++j) { const unsigned c = xb_ld(&bar[XB_XCNT(j)]); sum += c; cnt += (c > 0u) ? 1u : 0u; mine = (j == g.x) ? c : mine; }
        if (sum == gridDim.x) break;
        __builtin_amdgcn_s_sleep(1);
      }
      g.nloc = mine; g.nx = cnt;
    }
    const unsigned old = xb_add(&bar[XB_XSUB(g.x)], 1u);
    const unsigned gen = old / g.nloc;
    if (old + 1u == (gen + 1u) * g.nloc) {
      __builtin_amdgcn_fence(__ATOMIC_RELEASE, "agent");
      asm volatile("s_waitcnt vmcnt(0)" ::: "memory");
      const unsigned og = xb_add(&bar[XB_TOP], 1u);
      const unsigned tg = og / g.nx;
      if (og + 1u == (tg + 1u) * g.nx) xb_add(&bar[XB_TOPGEN], 1u);
      else while (xb_ld(&bar[XB_TOPGEN]) == tg) __builtin_amdgcn_s_sleep(1);
      __builtin_amdgcn_fence(__ATOMIC_ACQUIRE, "agent");
      xb_add(&bar[XB_XGEN(g.x)], 1u);
      asm volatile("s_waitcnt vmcnt(0)" ::: "memory");
    } else {
      while (xb_ld(&bar[XB_XGEN(g.x)]) == gen) __builtin_amdgcn_s_sleep(1);
      __builtin_amdgcn_fence(__ATOMIC_ACQUIRE, "agent");
      asm volatile("s_waitcnt vmcnt(0)" ::: "memory");
    }
  }
  __syncthreads();
}

struct SmemGemm { u16 a[2][128][72]; u16 b[2][128][72]; };
struct SmemAttn { u16 k[2][64][104]; u16 vt[2][64][72]; };
struct SmemScan { float vec[2][16][5][64]; float v[2][16][16]; float yp[16][16][16]; };
union __attribute__((aligned(16))) Smem { SmemGemm g; SmemAttn at; SmemScan sc; };

typedef __attribute__((ext_vector_type(4))) unsigned int u32x4;
#define G_LOAD(R, k0) do { \
    R##a0 = *(const u32x4*)(Ap + (k0)); R##a1 = *(const u32x4*)(Ap + sa32 + (k0)); R##a2 = *(const u32x4*)(Ap + 2 * sa32 + (k0)); R##a3 = *(const u32x4*)(Ap + 3 * sa32 + (k0)); \
    R##b0 = *(const u32x4*)(Bp + (k0)); R##b1 = *(const u32x4*)(Bp + sb32 + (k0)); R##b2 = *(const u32x4*)(Bp + 2 * sb32 + (k0)); R##b3 = *(const u32x4*)(Bp + 3 * sb32 + (k0)); } while (0)
#define G_STORE(buf, R) do { \
    *(u32x4*)&sm.a[buf][lrow][lkc] = R##a0; *(u32x4*)&sm.a[buf][lrow + 32][lkc] = R##a1; *(u32x4*)&sm.a[buf][lrow + 64][lkc] = R##a2; *(u32x4*)&sm.a[buf][lrow + 96][lkc] = R##a3; \
    *(u32x4*)&sm.b[buf][lrow][lkc] = R##b0; *(u32x4*)&sm.b[buf][lrow + 32][lkc] = R##b1; *(u32x4*)&sm.b[buf][lrow + 64][lkc] = R##b2; *(u32x4*)&sm.b[buf][lrow + 96][lkc] = R##b3; } while (0)
#define G_COMPUTE_LOW(buf) do {     \
    _Pragma("unroll") for (int s = 0; s < 4; s++) { \
      bf16x8 af[2], bfr[2]; \
      _Pragma("unroll") for (int i = 0; i < 2; i++) af[i] = *(const bf16x8*)&sm.a[buf][wm * 64 + i * 32 + r][s * 16 + h * 8]; \
      _Pragma("unroll") for (int j = 0; j < 2; j++) bfr[j] = *(const bf16x8*)&sm.b[buf][wn * 64 + j * 32 + r][s * 16 + h * 8]; \
      _Pragma("unroll") for (int i = 0; i < 2; i++) \
        _Pragma("unroll") for (int j = 0; j < 2; j++) acc[i][j] = __builtin_amdgcn_mfma_f32_32x32x16_bf16(af[i], bfr[j], acc[i][j], 0, 0, 0); \
    } } while (0)
#define G_COMPUTE(buf) do { \
    if (VAR == 1) { G_COMPUTE_LOW(buf); break; } \
    _Pragma("unroll") for (int hs = 0; hs < 2; hs++) {     \
      bf16x8 af[2][2], bfr[2][2]; \
      _Pragma("unroll") for (int s = 0; s < 2; s++) { \
        _Pragma("unroll") for (int i = 0; i < 2; i++) af[s][i] = *(const bf16x8*)&sm.a[buf][wm * 64 + i * 32 + r][(hs * 2 + s) * 16 + h * 8]; \
        _Pragma("unroll") for (int j = 0; j < 2; j++) bfr[s][j] = *(const bf16x8*)&sm.b[buf][wn * 64 + j * 32 + r][(hs * 2 + s) * 16 + h * 8]; \
      } \
      __builtin_amdgcn_sched_barrier(0); \
      _Pragma("unroll") for (int s = 0; s < 2; s++) \
        _Pragma("unroll") for (int i = 0; i < 2; i++) \
          _Pragma("unroll") for (int j = 0; j < 2; j++) acc[i][j] = __builtin_amdgcn_mfma_f32_32x32x16_bf16(af[s][i], bfr[s][j], acc[i][j], 0, 0, 0); \
      __builtin_amdgcn_sched_barrier(0); \
    } \
  } while (0)
#define G_STEP(kt, bufc, bufn) do { \
    const int kl_ = ((kt) + 2 < nk) ? (kt) + 2 : nk - 1;     \
    G_COMPUTE(bufc); \
    G_STORE(bufn, R0); \
    G_LOAD(R0, kl_ << 6); \
    __syncthreads(); } while (0)

template <int VAR = 0> DI void gemm_tile_acc(const u16* __restrict__ A, int lda, const u16* __restrict__ Bt, int ldb, int K,
                      int m0, int n0, f32x16 (&acc)[2][2], SmemGemm& sm) {
  const int tid = threadIdx.x, lane = tid & 63, w = tid >> 6, wm = w >> 1, wn = w & 1, r = lane & 31, h = lane >> 5;
  const int lrow = tid >> 3, lkc = (tid & 7) * 8;
  const u16* Ap = A + (size_t)(m0 + lrow) * lda + lkc;
  const u16* Bp = Bt + (size_t)(n0 + lrow) * ldb + lkc;
  const size_t sa32 = (size_t)32 * lda, sb32 = (size_t)32 * ldb;
  const int nk = K >> 6;
  u32x4 R0a0, R0a1, R0a2, R0a3, R0b0, R0b1, R0b2, R0b3;
  G_LOAD(R0, 0);
  __syncthreads();
  G_STORE(0, R0);
  if (nk == 1) {
    __syncthreads();
    G_COMPUTE(0);
    __syncthreads();
    return;
  }
  G_LOAD(R0, 64);
  __syncthreads();
  __builtin_amdgcn_s_setprio(1);
#pragma unroll 1
  for (int kt = 0; kt < nk; kt += 2) {
    G_STEP(kt, 0, 1);
    G_STEP(kt + 1, 1, 0);
  }
  __builtin_amdgcn_s_setprio(0);
}

DI void gemm_tile_dual(const u16* __restrict__ A1, const u16* __restrict__ B1, const u16* __restrict__ A2, const u16* __restrict__ B2,
                       int lda, int ldb, int m0, int n0, f32x16 (&acc)[2][2], u32 (&pk1)[2][2][8], SmemGemm& sm) {
  constexpr int VAR = 1;
  const int tid = threadIdx.x, lane = tid & 63, w = tid >> 6, wm = w >> 1, wn = w & 1, r = lane & 31, h = lane >> 5;
  const int lrow = tid >> 3, lkc = (tid & 7) * 8;
  const u16* A1p = A1 + (size_t)(m0 + lrow) * lda + lkc;
  const u16* B1p = B1 + (size_t)(n0 + lrow) * ldb + lkc;
  const u16* A2p = A2 + (size_t)(m0 + lrow) * lda + lkc;
  const u16* B2p = B2 + (size_t)(n0 + lrow) * ldb + lkc;
  const size_t sa32 = (size_t)32 * lda, sb32 = (size_t)32 * ldb;
  constexpr int nk = 16;
  u32x4 R0a0, R0a1, R0a2, R0a3, R0b0, R0b1, R0b2, R0b3;
#define GD_LOAD(kl) do { const int kl_ = (kl) < nk ? (kl) : nk - 1; \
    const u16* Ap = (kl_ < 8) ? A1p : A2p; const u16* Bp = (kl_ < 8) ? B1p : B2p; G_LOAD(R0, (kl_ & 7) << 6); } while (0)
#define GD_STEP(kt, bufc, bufn) do { G_COMPUTE(bufc); G_STORE(bufn, R0); GD_LOAD((kt) + 2); __syncthreads(); } while (0)
  GD_LOAD(0);
  __syncthreads();
  G_STORE(0, R0);
  GD_LOAD(1);
  __syncthreads();
  __builtin_amdgcn_s_setprio(1);
#pragma unroll 1
  for (int kt = 0; kt < nk; kt += 2) {
    if (kt == 8) {
#pragma unroll
      for (int i = 0; i < 2; i++)
#pragma unroll
        for (int j = 0; j < 2; j++) {
#pragma unroll
          for (int q = 0; q < 8; q++) pk1[i][j][q] = pack2(acc[i][j][2 * q], acc[i][j][2 * q + 1]);
#pragma unroll
          for (int g = 0; g < 16; g++) acc[i][j][g] = 0.f;
        }
    }
    GD_STEP(kt, 0, 1);
    GD_STEP(kt + 1, 1, 0);
  }
  __builtin_amdgcn_s_setprio(0);
}

DI void acc_zero(f32x16 (&acc)[2][2]) {
#pragma unroll
  for (int i = 0; i < 2; i++)
#pragma unroll
    for (int j = 0; j < 2; j++)
#pragma unroll
      for (int g = 0; g < 16; g++) acc[i][j][g] = 0.f;
}

DI void acc_stage(f32x16 (&acc)[2][2], SmemGemm& sm) {
  const int lane = threadIdx.x & 63, w = threadIdx.x >> 6, r = lane & 31, h = lane >> 5;
  float* wb = (float*)&sm + w * (64 * 68);
#pragma unroll
  for (int i = 0; i < 2; i++)
#pragma unroll
    for (int j = 0; j < 2; j++)
#pragma unroll
      for (int g = 0; g < 16; g++)
        wb[(i * 32 + (g & 3) + 8 * (g >> 2) + 4 * h) * 68 + j * 32 + r] = acc[i][j][g];
  __syncthreads();
}
template <class F> DI void acc_drain(int m0, int n0, SmemGemm& sm, F f) {
  const int lane = threadIdx.x & 63, w = threadIdx.x >> 6, wm = w >> 1, wn = w & 1;
  const float* wb = (const float*)&sm + w * (64 * 68);
  const int rl = lane >> 4, c4 = (lane & 15) * 4;
#pragma unroll 4
  for (int it = 0; it < 16; it++) {
    const int row_l = it * 4 + rl;
    const float4 v = *(const float4*)&wb[row_l * 68 + c4];
    f(m0 + wm * 64 + row_l, n0 + wn * 64 + c4, v);
  }
}
template <class F> DI void acc_epilogue(f32x16 (&acc)[2][2], int m0, int n0, SmemGemm& sm, F f) {
  acc_stage(acc, sm);
  acc_drain(m0, n0, sm, f);
}

template <class F> DI void acc_epilogue2(const u32 (&pk1)[2][2][8], f32x16 (&acc2)[2][2], int m0, int n0, SmemGemm& sm, F f) {
  const int lane = threadIdx.x & 63, w = threadIdx.x >> 6, wm = w >> 1, wn = w & 1, r = lane & 31, h = lane >> 5;
  float* wb = (float*)&sm + w * (64 * 68);
  const int rl = lane >> 4, c4 = (lane & 15) * 4;
  int lz;
  asm volatile("v_mov_b32 %0, 0" : "=v"(lz));
  m0 += lz;
  uint2 v1[16];
#pragma unroll
  for (int i = 0; i < 2; i++)
#pragma unroll
    for (int j = 0; j < 2; j++)
#pragma unroll
      for (int q = 0; q < 8; q++) {
        const int g0 = 2 * q, g1 = 2 * q + 1;
        wb[(i * 32 + (g0 & 3) + 8 * (g0 >> 2) + 4 * h) * 68 + j * 32 + r] = __uint_as_float(pk1[i][j][q] << 16);
        wb[(i * 32 + (g1 & 3) + 8 * (g1 >> 2) + 4 * h) * 68 + j * 32 + r] = __uint_as_float(pk1[i][j][q] & 0xffff0000u);
      }
  __syncthreads();
#pragma unroll
  for (int it = 0; it < 16; it++) {
    const float4 t = *(const float4*)&wb[(it * 4 + rl) * 68 + c4];
    v1[it] = make_uint2(pack2(t.x, t.y), pack2(t.z, t.w));
  }
  __syncthreads();
#pragma unroll
  for (int i = 0; i < 2; i++)
#pragma unroll
    for (int j = 0; j < 2; j++)
#pragma unroll
      for (int g = 0; g < 16; g++)
        wb[(i * 32 + (g & 3) + 8 * (g >> 2) + 4 * h) * 68 + j * 32 + r] = acc2[i][j][g];
  __syncthreads();
#pragma unroll
  for (int it = 0; it < 16; it++) {
    const int row_l = it * 4 + rl;
    const float4 v2 = *(const float4*)&wb[row_l * 68 + c4];
    const float4 va = make_float4(__uint_as_float(v1[it].x << 16), __uint_as_float(v1[it].x & 0xffff0000u),
                                  __uint_as_float(v1[it].y << 16), __uint_as_float(v1[it].y & 0xffff0000u));
    f(m0 + wm * 64 + row_l, n0 + wn * 64 + c4, va, v2);
  }
}

DI float4 silu4(float4 v) { return make_float4(siluf_(v.x), siluf_(v.y), siluf_(v.z), siluf_(v.w)); }
DI float4 sigm4(float4 v) { return make_float4(sigmoidf_(v.x), sigmoidf_(v.y), sigmoidf_(v.z), sigmoidf_(v.w)); }

DI void transpose_cvt(const float* __restrict__ src, int K, int N, u16* __restrict__ dst, int ldd, const float* __restrict__ kscale,
                      long gtid, long nth) {
  const long tot = (long)(K >> 3) * N;
  for (long idx = gtid; idx < tot; idx += nth) {
    const int kb = (int)(idx / N), n = (int)(idx - (long)kb * N), k0 = kb * 8;
    float v[8];
#pragma unroll
    for (int j = 0; j < 8; j++) v[j] = src[(size_t)(k0 + j) * N + n];
    if (kscale) {
#pragma unroll
      for (int j = 0; j < 8; j++) v[j] *= kscale[k0 + j];
    }
    uint4 o;
    o.x = pack2(v[0], v[1]); o.y = pack2(v[2], v[3]); o.z = pack2(v[4], v[5]); o.w = pack2(v[6], v[7]);
    *(uint4*)(dst + (size_t)n * ldd + k0) = o;
  }
}

DI void phase0(const Params& p) {
  const long gtid = (long)blockIdx.x * 256 + threadIdx.x, nth = (long)gridDim.x * 256;
  char* ws = p.ws;
  transpose_cvt(p.w_in, 1024, INC, (u16*)(ws + O_WIN), LDU, nullptr, gtid, nth);
  for (long idx = gtid; idx < (long)(INP - INC) * LDU; idx += nth) ((u16*)(ws + O_WIN))[(size_t)INC * LDU + idx] = 0;
  transpose_cvt(p.w_uq, 256, 768, (u16*)(ws + O_WUQ), LDQW, p.g_q, gtid, nth);
  transpose_cvt(p.w_ukv, 128, 1024, (u16*)(ws + O_WUKV), 128, p.g_kv, gtid, nth);
  transpose_cvt(p.w_oa, 512, 1024, (u16*)(ws + O_WOA), LDY, nullptr, gtid, nth);
  transpose_cvt(p.w_ob, 512, 1024, (u16*)(ws + O_WOB), LDY, nullptr, gtid, nth);
  transpose_cvt(p.w_o, 1024, 1024, (u16*)(ws + O_WO), LDU, nullptr, gtid, nth);
  transpose_cvt(p.w_dec, 64, 512, (u16*)(ws + O_WDEC), 64, nullptr, gtid, nth);
  transpose_cvt(p.w_icl, 64, 512, (u16*)(ws + O_WICL), 64, nullptr, gtid, nth);

  const int lane = threadIdx.x & 63;
  const long wave = gtid >> 6, nw = nth >> 6;
  u16* U = (u16*)(ws + O_U);
  for (long row = wave; row < T; row += nw) {
    const float4* xr = (const float4*)(p.x + row * 1024);
    float4 v[4];
    float ss = 0.f;
#pragma unroll
    for (int i = 0; i < 4; i++) { v[i] = xr[lane + 64 * i]; ss += v[i].x * v[i].x + v[i].y * v[i].y + v[i].z * v[i].z + v[i].w * v[i].w; }
    ss = wave_sum(ss);
    const float rs = rsqrtf(ss * (1.f / 1024.f) + NORM_EPS);
#pragma unroll
    for (int i = 0; i < 4; i++) {
      float4 g = ((const float4*)p.g_pre)[lane + 64 * i];
      uint2 o;
      o.x = pack2(v[i].x * rs * g.x, v[i].y * rs * g.y);
      o.y = pack2(v[i].z * rs * g.z, v[i].w * rs * g.w);
      *(uint2*)(U + row * LDU + (lane + 64 * i) * 4) = o;
    }
  }
}

DI void phase1(const Params& p, Smem& sm, int* cnt) {
  char* ws = p.ws;
  const u16* U = (const u16*)(ws + O_U);
  const u16* W = (const u16*)(ws + O_WIN);
  u16* FA = (u16*)(ws + O_FA); u16* SZA = (u16*)(ws + O_SZA); u16* SZB = (u16*)(ws + O_SZB);
  u16* CQKV = (u16*)(ws + O_CQKV); u16* G = (u16*)(ws + O_G);
  const float* bg = p.b_gate;
  const int xcd = blockIdx.x & 7, lb = blockIdx.x >> 3, nlb = gridDim.x >> 3;
  for (int li = lb; li < 32 * 41; li += nlb) {
    const int g = li / 328, rem = li - g * 328, nt = rem >> 3, mt = xcd * 32 + g * 8 + (rem & 7);
    f32x16 acc[2][2];
    acc_zero(acc);
    gemm_tile_acc(U, LDU, W, LDU, 1024, mt * 128, nt * 128, acc, sm.g);
    acc_stage(acc, sm.g);
    const int cw = __builtin_amdgcn_readfirstlane(nt * 128 + ((threadIdx.x >> 6) & 1) * 64);
    const int m0 = mt * 128, n0 = nt * 128;
    if (cw + 64 <= C_ZA) {
      acc_drain(m0, n0, sm.g, [&](int row, int col, float4 v) { st4(FA + (size_t)row * FAW + col, v); });
    } else if (cw >= C_ZA && cw + 64 <= C_CQ) {
      acc_drain(m0, n0, sm.g, [&](int row, int col, float4 v) { st4(SZA + (size_t)row * 512 + (col - C_ZA), silu4(v)); });
    } else if (cw >= C_ZB && cw + 64 <= C_G) {
      acc_drain(m0, n0, sm.g, [&](int row, int col, float4 v) { st4(SZB + (size_t)row * 512 + (col - C_ZB), silu4(v)); });
    } else if (cw >= C_G && cw + 64 <= INC) {
      const float4 bb = *(const float4*)(bg + (n0 + ((threadIdx.x >> 6) & 1) * 64 + (threadIdx.x & 15) * 4 - C_G));
      acc_drain(m0, n0, sm.g, [&](int row, int col, float4 v) {
        st4(G + (size_t)row * LDG + (col - C_G), sigm4(make_float4(v.x + bb.x, v.y + bb.y, v.z + bb.z, v.w + bb.w)));
      });
    } else {
      acc_drain(m0, n0, sm.g, [&](int row, int col, float4 v) {
        if (col < C_ZA) st4(FA + (size_t)row * FAW + col, v);
        else if (col < C_CQ) st4(SZA + (size_t)row * 512 + (col - C_ZA), silu4(v));
        else if (col < C_ZB) st4(CQKV + (size_t)row * CQW + (col - C_CQ), v);
        else if (col < C_G) st4(SZB + (size_t)row * 512 + (col - C_ZB), silu4(v));
        else if (col < INC) {
          const float4 bb = *(const float4*)(bg + (col - C_G));
          st4(G + (size_t)row * LDG + (col - C_G), sigm4(make_float4(v.x + bb.x, v.y + bb.y, v.z + bb.z, v.w + bb.w)));
        }
      });
    }
  }
}

DI void phase2(const Params& p) {
  const long gtid = (long)blockIdx.x * 256 + threadIdx.x, nth = (long)gridDim.x * 256;
  const int lane = threadIdx.x & 63, sub = lane >> 4, l16 = lane & 15;
  const long wave = gtid >> 6, nw = nth >> 6;
  char* ws = p.ws;
  const u16* FA = (const u16*)(ws + O_FA);
  const u16* CQKV = (const u16*)(ws + O_CQKV);
  u16* LA = (u16*)((char*)p.out + D_LA);
  u16* Kb = (u16*)(ws + O_K);
  float* RSQ = (float*)(ws + O_RSQ); float* RSKV = (float*)(ws + O_RSKV);
  float* CS = (float*)(ws + O_CS);
  const float4 mu_wd = *(const float4*)(p.mu + 1536 + l16 * 4), mu_ad = *(const float4*)(p.mu + 1600 + l16 * 4);
  const float inv_freq = powf(10000.0f, -(float)l16 / 16.0f);
  for (long it = wave; it < T / 4; it += nw) {
    const long t = it * 4 + sub;
    const int s = (int)(t & (SEQ - 1)), b = (int)(t >> 12);
    const u16* fa = FA + t * FAW;
    const u16* fp = (s > 0) ? fa - FAW : fa;
    {
      const float4 f = ld4(fa + 1536 + l16 * 4);
      float4 pv = ld4(fp + 1536 + l16 * 4);
      if (s == 0) pv = make_float4(0.f, 0.f, 0.f, 0.f);
      st4(LA + t * 128 + l16 * 4, make_float4(tanhf(f.x + mu_wd.x * (pv.x - f.x)), tanhf(f.y + mu_wd.y * (pv.y - f.y)),
                                              tanhf(f.z + mu_wd.z * (pv.z - f.z)), tanhf(f.w + mu_wd.w * (pv.w - f.w))));
      const float4 f2 = ld4(fa + 1600 + l16 * 4);
      float4 pv2 = ld4(fp + 1600 + l16 * 4);
      if (s == 0) pv2 = make_float4(0.f, 0.f, 0.f, 0.f);
      st4(LA + t * 128 + 64 + l16 * 4, make_float4(f2.x + mu_ad.x * (pv2.x - f2.x), f2.y + mu_ad.y * (pv2.y - f2.y),
                                                   f2.z + mu_ad.z * (pv2.z - f2.z), f2.w + mu_ad.w * (pv2.w - f2.w)));
    }
    const u16* c = CQKV + t * CQW;
    float ss = 0.f, ss2 = 0.f;
#pragma unroll
    for (int i = 0; i < 4; i++) { const float4 v = ld4(c + i * 64 + l16 * 4); ss += (v.x * v.x + v.y * v.y) + (v.z * v.z + v.w * v.w); }
#pragma unroll
    for (int i = 0; i < 2; i++) { const float4 v = ld4(c + 256 + i * 64 + l16 * 4); ss2 += (v.x * v.x + v.y * v.y) + (v.z * v.z + v.w * v.w); }
    ss = row16_sum(ss);
    ss2 = row16_sum(ss2);
    if (l16 == 0) {
      RSQ[t] = rsqrtf(ss * (1.f / 256.f) + NORM_EPS);
      RSKV[t] = rsqrtf(ss2 * (1.f / 128.f) + NORM_EPS);
    }
    {
      const float t1 = bf2f(c[384 + l16]), t2 = bf2f(c[400 + l16]);
      const float ang = (float)p.pos[t] * inv_freq;
      const float cs = cosf(ang), sn = sinf(ang);
      CS[t * 32 + l16] = cs;
      CS[t * 32 + 16 + l16] = sn;
      const u16 o1 = f2bf(t1 * cs - t2 * sn), o2 = f2bf(t2 * cs + t1 * sn);
#pragma unroll
      for (int hh = 0; hh < 8; hh++) {
        const size_t base = ((size_t)(b * 8 + hh) * SEQ + s) * 96 + 64;
        Kb[base + l16] = o1;
        Kb[base + 16 + l16] = o2;
      }
    }
  }
}

DI void kv_epilogue(f32x16 (&acc)[2][2], int m0, int hh, SmemGemm& sm, const float* __restrict__ RSKV, u16* __restrict__ Kb, u16* __restrict__ Vt) {
  const int lane = threadIdx.x & 63, w = threadIdx.x >> 6, wm = w >> 1, wn = w & 1, r = lane & 31, h = lane >> 5;
  float* wb = (float*)&sm + w * (64 * 68);
#pragma unroll
  for (int i = 0; i < 2; i++)
#pragma unroll
    for (int j = 0; j < 2; j++)
#pragma unroll
      for (int g = 0; g < 16; g++)
        wb[(i * 32 + (g & 3) + 8 * (g >> 2) + 4 * h) * 68 + j * 32 + r] = acc[i][j][g];
  __syncthreads();
  const int row0 = m0 + wm * 64, b = row0 >> 12, s0 = row0 & (SEQ - 1);
  if (wn == 0) {
    const int rl = lane >> 4, c4 = (lane & 15) * 4;
#pragma unroll 4
    for (int it = 0; it < 16; it++) {
      const int row_l = it * 4 + rl;
      float4 v = *(const float4*)&wb[row_l * 68 + c4];
      const float rs = RSKV[row0 + row_l];
      v.x *= rs; v.y *= rs; v.z *= rs; v.w *= rs;
      st4(Kb + ((size_t)(b * 8 + hh) * SEQ + s0 + row_l) * 96 + c4, v);
    }
  } else {
    u16* vp = Vt + ((size_t)(b * 8 + hh) * 64 + lane) * LDV + s0;
#pragma unroll 4
    for (int rg = 0; rg < 16; rg++) {
      const float4 rs = *(const float4*)(RSKV + row0 + rg * 4);
      float4 v;
      v.x = wb[(rg * 4 + 0) * 68 + lane] * rs.x; v.y = wb[(rg * 4 + 1) * 68 + lane] * rs.y;
      v.z = wb[(rg * 4 + 2) * 68 + lane] * rs.z; v.w = wb[(rg * 4 + 3) * 68 + lane] * rs.w;
      st4(vp + rg * 4, v);
    }
  }
}

DI void phase3(const Params& p, Smem& sm, int* cnt) {
  char* ws = p.ws;
  const u16* LA = (const u16*)((char*)p.out + D_LA);
  const u16* CQKV = (const u16*)(ws + O_CQKV);
  u16* NLW = (u16*)(ws + O_U);
  u16* Ab = (u16*)(ws + O_U + (size_t)T * 512 * 2);
  u16* Qb = (u16*)(ws + O_Q);
  u16* Kb = (u16*)(ws + O_K);
  u16* Vt = (u16*)((char*)p.out + D_VT);
  const float* RSQ = (const float*)(ws + O_RSQ);
  const float* RSKV = (const float*)(ws + O_RSKV);
  const float* CS = (const float*)(ws + O_CS);
  const float qscale = 1.4426950408889634f * 0.10206207261596575f;
  const int n_dec = 32 * 4, n_icl = 32 * 4, n_q = 32 * 6, n_kv = 32 * 8;
  const int xcd = blockIdx.x & 7, lb = blockIdx.x >> 3, nlb = gridDim.x >> 3;
  for (int li = lb; li < n_dec + n_icl + n_q + n_kv; li += nlb) {
    f32x16 acc[2][2];
    acc_zero(acc);
    if (li < n_dec) {
      const int mt = xcd * 32 + (li >> 2), nt = li & 3;
      gemm_tile_acc(LA, 128, (const u16*)(ws + O_WDEC), 64, 64, mt * 128, nt * 128, acc, sm.g);
      const float* w0 = p.w0;
      const float4 ww = *(const float4*)(w0 + nt * 128 + ((threadIdx.x >> 6) & 1) * 64 + (threadIdx.x & 15) * 4);
      acc_epilogue(acc, mt * 128, nt * 128, sm.g, [&](int row, int col, float4 v) {
        st4(NLW + (size_t)row * 512 + col, make_float4(1.f - __expf(-DECAY_SCALE * sigmoidf_(ww.x + v.x)), 1.f - __expf(-DECAY_SCALE * sigmoidf_(ww.y + v.y)),
                                                       1.f - __expf(-DECAY_SCALE * sigmoidf_(ww.z + v.z)), 1.f - __expf(-DECAY_SCALE * sigmoidf_(ww.w + v.w))));
      });
    } else if (li < n_dec + n_icl) {
      const int tt = li - n_dec, mt = xcd * 32 + (tt >> 2), nt = tt & 3;
      gemm_tile_acc(LA + 64, 128, (const u16*)(ws + O_WICL), 64, 64, mt * 128, nt * 128, acc, sm.g);
      const float* a0 = p.a0;
      const float4 aa = *(const float4*)(a0 + nt * 128 + ((threadIdx.x >> 6) & 1) * 64 + (threadIdx.x & 15) * 4);
      acc_epilogue(acc, mt * 128, nt * 128, sm.g, [&](int row, int col, float4 v) {
        st4(Ab + (size_t)row * 512 + col, sigm4(make_float4(aa.x + v.x, aa.y + v.y, aa.z + v.z, aa.w + v.w)));
      });
    } else if (li < n_dec + n_icl + n_q) {
      const int tt = li - n_dec - n_icl, ml = tt / 6, nt = tt - ml * 6, mt = xcd * 32 + ml;
      gemm_tile_acc(CQKV, CQW, (const u16*)(ws + O_WUQ), LDQW, 256, mt * 128, nt * 128, acc, sm.g);
      acc_epilogue(acc, mt * 128, nt * 128, sm.g, [&](int row, int col, float4 v) {
        const int hh = col / 96, d = col - hh * 96, b = row >> 12, s = row & (SEQ - 1);
        const float rs = RSQ[row] * qscale;
        v.x *= rs; v.y *= rs; v.z *= rs; v.w *= rs;
        float4 pv;
        {
          const bool up = (d < 80);
          const float ax = dpp_mov<0x104>(v.x), bx = dpp_mov<0x114>(v.x);
          const float ay = dpp_mov<0x104>(v.y), by = dpp_mov<0x114>(v.y);
          const float az = dpp_mov<0x104>(v.z), bz = dpp_mov<0x114>(v.z);
          const float aw = dpp_mov<0x104>(v.w), bw = dpp_mov<0x114>(v.w);
          pv.x = up ? ax : bx; pv.y = up ? ay : by; pv.z = up ? az : bz; pv.w = up ? aw : bw;
        }
        if (d >= 64) {
          const int i = (d - 64) & 15;
          const float4 cs = *(const float4*)(CS + (size_t)row * 32 + i);
          const float4 sn = *(const float4*)(CS + (size_t)row * 32 + 16 + i);
          const float sg = (d < 80) ? -1.f : 1.f;
          v.x = v.x * cs.x + sg * pv.x * sn.x; v.y = v.y * cs.y + sg * pv.y * sn.y;
          v.z = v.z * cs.z + sg * pv.z * sn.z; v.w = v.w * cs.w + sg * pv.w * sn.w;
        }
        st4(Qb + ((size_t)(b * 8 + hh) * SEQ + s) * 96 + d, v);
      });
    } else {
      const int tt = li - n_dec - n_icl - n_q, mt = xcd * 32 + (tt >> 3), nt = tt & 7;
      gemm_tile_acc(CQKV + 256, CQW, (const u16*)(ws + O_WUKV), 128, 128, mt * 128, nt * 128, acc, sm.g);
      kv_epilogue(acc, mt * 128, nt, sm.g, RSKV, Kb, Vt);
    }
  }
}

DI void scan_item(const Params& p, int item, SmemScan& sm) {
  const int tid = threadIdx.x, lane = tid & 63, w = tid >> 6;
  const int vg = item & 3, bh = item >> 2, hh = bh & 7, b = bh >> 3;
  char* ws = p.ws;
  const u16* FA = (const u16*)(ws + O_FA);
  const u16* NLW = (const u16*)(ws + O_U);
  const u16* Ab = (const u16*)(ws + O_U + (size_t)T * 512 * 2);
  float* BONUS = (float*)(ws + O_BONUS);
  u16* Y = (u16*)((char*)p.out + D_YA);
  const int st = tid >> 4, kq = tid & 15, col = hh * 64 + kq * 4;
  float mu_r[4], mu_k[4], mu_v[4], ckk[4], cka[4], crk[4], omc[4];
#pragma unroll
  for (int i = 0; i < 4; i++) {
    mu_r[i] = p.mu[col + i]; mu_k[i] = p.mu[512 + col + i]; mu_v[i] = p.mu[1024 + col + i];
    ckk[i] = p.k_k[col + i]; cka[i] = p.k_a[col + i]; crk[i] = p.r_k[col + i]; omc[i] = 1.f - cka[i];
  }
  struct SIn { uint2 rf, rp, kf, kp, vf, vp, a, w; };
  auto issue = [&](int tc, SIn& g) {
    const int s = tc + st;
    const size_t t = (size_t)b * SEQ + s;
    const u16* fa = FA + t * FAW + col;
    const u16* fp = (s > 0) ? fa - FAW : fa;
    g.rf = *(const uint2*)(fa);
    g.kf = *(const uint2*)(fa + 512);
    g.vf = *(const uint2*)(fa + 1024);
    g.rp = *(const uint2*)(fp);
    g.kp = *(const uint2*)(fp + 512);
    g.vp = *(const uint2*)(fp + 1024);
    g.a = *(const uint2*)(Ab + t * 512 + col);
    g.w = *(const uint2*)(NLW + t * 512 + col);
  };
  auto unp = [](uint2 u, float (&f)[4]) {
    f[0] = __uint_as_float(u.x << 16); f[1] = __uint_as_float(u.x & 0xffff0000u);
    f[2] = __uint_as_float(u.y << 16); f[3] = __uint_as_float(u.y & 0xffff0000u);
  };
  auto process = [&](int tc, const SIn& g, int pb) {
    float rf[4], rp[4], kf[4], kp[4], vf[4], vp[4], av[4], nl[4];
    unp(g.rf, rf); unp(g.rp, rp); unp(g.kf, kf); unp(g.kp, kp); unp(g.vf, vf); unp(g.vp, vp); unp(g.a, av); unp(g.w, nl);
    if (tc + st == 0) {
#pragma unroll
      for (int i = 0; i < 4; i++) { rp[i] = 0.f; kp[i] = 0.f; vp[i] = 0.f; }
    }
    float rr[4], ks[4], vs[4], kkr[4];
    float n2 = 0.f, bon = 0.f;
#pragma unroll
    for (int i = 0; i < 4; i++) {
      rr[i] = rf[i] + mu_r[i] * (rp[i] - rf[i]);
      ks[i] = kf[i] + mu_k[i] * (kp[i] - kf[i]);
      vs[i] = vf[i] + mu_v[i] * (vp[i] - vf[i]);
      kkr[i] = ks[i] * ckk[i];
      n2 += kkr[i] * kkr[i];
    }
    n2 = row16_sum(n2);
    const float inv = __builtin_amdgcn_rsqf(fmaxf(n2, 1e-24f));
    float4 o_w, o_kk, o_b, o_kx, o_r;
    float kx[4], kk[4];
#pragma unroll
    for (int i = 0; i < 4; i++) {
      kk[i] = kkr[i] * inv;
      kx[i] = ks[i] * (av[i] * cka[i] + omc[i]);
      bon += rr[i] * kx[i] * crk[i];
    }
    bon = row16_sum(bon);
    o_w = make_float4(1.f - nl[0], 1.f - nl[1], 1.f - nl[2], 1.f - nl[3]);
    o_kk = make_float4(kk[0], kk[1], kk[2], kk[3]);
    o_b = make_float4(kk[0] * av[0], kk[1] * av[1], kk[2] * av[2], kk[3] * av[3]);
    o_kx = make_float4(kx[0], kx[1], kx[2], kx[3]);
    o_r = make_float4(rr[0], rr[1], rr[2], rr[3]);
    *(float4*)&sm.vec[pb][st][0][kq * 4] = o_w;
    *(float4*)&sm.vec[pb][st][1][kq * 4] = o_kk;
    *(float4*)&sm.vec[pb][st][2][kq * 4] = o_b;
    *(float4*)&sm.vec[pb][st][3][kq * 4] = o_kx;
    *(float4*)&sm.vec[pb][st][4][kq * 4] = o_r;
    if ((kq >> 2) == vg) *(float4*)&sm.v[pb][st][(kq & 3) * 4] = make_float4(vs[0], vs[1], vs[2], vs[3]);
    if (vg == 0 && kq == 0) BONUS[((size_t)b * SEQ + tc + st) * 8 + hh] = bon;
  };
  const int vl = lane >> 4, kg = lane & 15;
  const int rowb = w * 4 + vl;
  f32x2 S01 = {0.f, 0.f}, S23 = {0.f, 0.f};
  const int ys = lane >> 2, yr = w * 4 + (lane & 3);
  SIn gA, gB;
  issue(0, gA);
  issue(16, gB);
  __syncthreads();
  process(0, gA, 0);
  __syncthreads();
#define LO2(v) (f32x2{(v).x, (v).y})
#define HI2(v) (f32x2{(v).z, (v).w})
#define SCAN_CHUNK(tc_, gfree, gnext, cb) do { \
    process(((tc_) + 16 < SEQ) ? (tc_) + 16 : SEQ - 16, gnext, (cb) ^ 1); \
    issue(((tc_) + 32 < SEQ) ? (tc_) + 32 : SEQ - 16, gfree); \
    float4 w4 = *(const float4*)&sm.vec[cb][0][0][kg * 4]; \
    float4 kk4 = *(const float4*)&sm.vec[cb][0][1][kg * 4]; \
    float4 b4 = *(const float4*)&sm.vec[cb][0][2][kg * 4]; \
    float4 kx4 = *(const float4*)&sm.vec[cb][0][3][kg * 4]; \
    float4 r4 = *(const float4*)&sm.vec[cb][0][4][kg * 4]; \
    float vv = sm.v[cb][0][rowb]; \
    _Pragma("unroll") for (int s = 0; s < 16; s++) { \
      const int sn = (s < 15) ? s + 1 : 15; \
      const float4 nw4 = *(const float4*)&sm.vec[cb][sn][0][kg * 4]; \
      const float4 nkk4 = *(const float4*)&sm.vec[cb][sn][1][kg * 4]; \
      const float4 nb4 = *(const float4*)&sm.vec[cb][sn][2][kg * 4]; \
      const float4 nkx4 = *(const float4*)&sm.vec[cb][sn][3][kg * 4]; \
      const float4 nr4 = *(const float4*)&sm.vec[cb][sn][4][kg * 4]; \
      const float nvv = sm.v[cb][sn][rowb]; \
      const f32x2 d2 = S23 * HI2(kk4) + S01 * LO2(kk4); \
      const f32x2 vv2 = {vv, vv}; \
      const f32x2 t01 = vv2 * LO2(kx4) + S01 * LO2(w4); \
      const f32x2 t23 = vv2 * HI2(kx4) + S23 * HI2(w4); \
      const float d = row16_sum(d2.x + d2.y); \
      const f32x2 dd = {d, d}; \
      S01 = t01 - dd * LO2(b4); \
      S23 = t23 - dd * HI2(b4); \
      const f32x2 y2 = S23 * HI2(r4) + S01 * LO2(r4); \
      sm.yp[s][rowb][kg] = y2.x + y2.y; \
      w4 = nw4; kk4 = nkk4; b4 = nb4; kx4 = nkx4; r4 = nr4; vv = nvv; \
    } \
    {     \
      const float4 p0 = *(const float4*)&sm.yp[ys][yr][0], p1 = *(const float4*)&sm.yp[ys][yr][4]; \
      const float4 p2 = *(const float4*)&sm.yp[ys][yr][8], p3 = *(const float4*)&sm.yp[ys][yr][12]; \
      const float y = ((p0.x + p0.y) + (p0.z + p0.w)) + ((p1.x + p1.y) + (p1.z + p1.w)) + ((p2.x + p2.y) + (p2.z + p2.w)) + ((p3.x + p3.y) + (p3.z + p3.w)); \
      Y[((size_t)b * SEQ + (tc_) + ys) * LDY + hh * 64 + vg * 16 + yr] = f2bf(y); \
    } \
    __syncthreads(); } while (0)
#pragma unroll 1
  for (int tc = 0; tc < SEQ; tc += 32) {
    SCAN_CHUNK(tc, gA, gB, 0);
    SCAN_CHUNK(tc + 16, gB, gA, 1);
  }
  __syncthreads();
}

DI void attn_item(const Params& p, int bh, int qb, SmemAttn& sm) {
  const int tid = threadIdx.x, lane = tid & 63, w = tid >> 6, r = lane & 31, h = lane >> 5;
  char* ws = p.ws;
  const u16* Qb = (const u16*)(ws + O_Q) + (size_t)bh * SEQ * 96;
  const u16* Kb = (const u16*)(ws + O_K) + (size_t)bh * SEQ * 96;
  const u16* Vt = (const u16*)((char*)p.out + D_VT) + (size_t)bh * 64 * LDV;
  const u16* SZB = (const u16*)(ws + O_SZB);
  u16* O = (u16*)((char*)p.out + D_O);
  const int b = bh >> 3, hh = bh & 7;
  const int q0 = qb * 128;
  const int qw = q0 + w * 32;
  const int qg = qw + r;
#if NAIVE_ATTN
  if (h == 0) {
    float m = -1e30f, l = 0.f;
    const size_t t = (size_t)b * SEQ + qg;
    for (int dc = 0; dc < 64; dc += 16) {
      float o[16];
      m = -1e30f; l = 0.f;
#pragma unroll
      for (int d = 0; d < 16; d++) o[d] = 0.f;
      for (int key = 0; key <= qg; key++) {
        float s = 0.f;
        for (int d = 0; d < 96; d++) s += bf2f(Qb[(size_t)qg * 96 + d]) * bf2f(Kb[(size_t)key * 96 + d]);
        float mn = fmaxf(m, s);
        float al = exp2f(m - mn), pp = exp2f(s - mn);
        l = l * al + pp;
#pragma unroll
        for (int d = 0; d < 16; d++) o[d] = o[d] * al + pp * bf2f(Vt[(size_t)(dc + d) * LDV + key]);
        m = mn;
      }
#pragma unroll
      for (int d = 0; d < 16; d++) O[t * LDY + hh * 64 + dc + d] = f2bf(o[d] / l * bf2f(SZB[t * 512 + hh * 64 + dc + d]));
    }
  }
#else
  bf16x8 bq[6];
#pragma unroll
  for (int s = 0; s < 6; s++) bq[s] = *(const bf16x8*)(Qb + (size_t)qg * 96 + s * 16 + h * 8);
  const f32x16 zero16 = {0.f, 0.f, 0.f, 0.f, 0.f, 0.f, 0.f, 0.f, 0.f, 0.f, 0.f, 0.f, 0.f, 0.f, 0.f, 0.f};
  f32x16 oacc[2];
#pragma unroll
  for (int g = 0; g < 16; g++) { oacc[0][g] = 0.f; oacc[1][g] = 0.f; }
  float m_run = -1e30f, l_run = 0.f;
  const int nkt = (q0 + 128) >> 6;
  u32x4 RK0, RK1, RK2, RV0, RV1;
  const int kr0 = tid / 12, kc0 = tid - kr0 * 12;
  const int kr1 = (tid + 256) / 12, kc1 = (tid + 256) - kr1 * 12;
  const int kr2 = (tid + 512) / 12, kc2 = (tid + 512) - kr2 * 12;
  const int vr0 = tid >> 3, vc0 = tid & 7;
#define ATT_KISSUE(kt_) do { const int k0_ = (((kt_) < nkt) ? (kt_) : nkt - 1) << 6; \
    RK0 = *(const u32x4*)(Kb + (size_t)(k0_ + kr0) * 96 + kc0 * 8); \
    RK1 = *(const u32x4*)(Kb + (size_t)(k0_ + kr1) * 96 + kc1 * 8); \
    RK2 = *(const u32x4*)(Kb + (size_t)(k0_ + kr2) * 96 + kc2 * 8); } while (0)
#define ATT_VISSUE(kt_) do { const int k0_ = (((kt_) < nkt) ? (kt_) : nkt - 1) << 6; \
    RV0 = *(const u32x4*)(Vt + (size_t)vr0 * LDV + k0_ + vc0 * 8); \
    RV1 = *(const u32x4*)(Vt + (size_t)(vr0 + 32) * LDV + k0_ + vc0 * 8); } while (0)
#define ATT_KSTASH(buf) do { \
    *(u32x4*)&sm.k[buf][kr0][kc0 * 8] = RK0; *(u32x4*)&sm.k[buf][kr1][kc1 * 8] = RK1; *(u32x4*)&sm.k[buf][kr2][kc2 * 8] = RK2; } while (0)
#define ATT_VSTASH(buf) do { \
    *(u32x4*)&sm.vt[buf][vr0][vc0 * 8] = RV0; *(u32x4*)&sm.vt[buf][vr0 + 32][vc0 * 8] = RV1; } while (0)
#define ATT_S(SD, buf) do { \
      _Pragma("unroll") for (int kb = 0; kb < 2; kb++) { \
        { const bf16x8 kf0 = *(const bf16x8*)&sm.k[buf][kb * 32 + r][h * 8]; \
          SD[kb] = __builtin_amdgcn_mfma_f32_32x32x16_bf16(kf0, bq[0], zero16, 0, 0, 0); } \
        _Pragma("unroll") for (int s = 1; s < 6; s++) { \
          const bf16x8 kf = *(const bf16x8*)&sm.k[buf][kb * 32 + r][s * 16 + h * 8]; \
          SD[kb] = __builtin_amdgcn_mfma_f32_32x32x16_bf16(kf, bq[s], SD[kb], 0, 0, 0); \
        } \
      } } while (0)
#define ATT_SMPV(sacc, kt, buf) do { \
      const int k0 = (kt) << 6; \
      if (k0 + 63 > qw) { \
        _Pragma("unroll") for (int kb = 0; kb < 2; kb++) \
          _Pragma("unroll") for (int g = 0; g < 16; g++) { \
            const int key = k0 + kb * 32 + (g & 3) + 8 * (g >> 2) + 4 * h; \
            if (key > qg) sacc[kb][g] = -1e30f; \
          } \
      } \
      float mloc = -1e30f; \
      _Pragma("unroll") for (int kb = 0; kb < 2; kb++) \
        _Pragma("unroll") for (int g = 0; g < 16; g++) mloc = fmaxf(mloc, sacc[kb][g]); \
      mloc = fmaxf(mloc, __shfl_xor(mloc, 32, 64)); \
      const float m_new = fmaxf(m_run, mloc); \
      if (__any(m_new > m_run)) { \
        const float alpha = __builtin_amdgcn_exp2f(m_run - m_new); \
        l_run *= alpha; \
        _Pragma("unroll") for (int g = 0; g < 16; g++) { oacc[0][g] *= alpha; oacc[1][g] *= alpha; } \
        m_run = m_new; \
      } \
      float psum = 0.f; \
      _Pragma("unroll") for (int kb = 0; kb < 2; kb++) \
        _Pragma("unroll") for (int g = 0; g < 16; g++) { \
          const float pv = __builtin_amdgcn_exp2f(sacc[kb][g] - m_run); \
          sacc[kb][g] = pv; \
          psum += pv; \
        } \
      l_run += psum; \
      _Pragma("unroll") for (int kb = 0; kb < 2; kb++) \
        _Pragma("unroll") for (int sp = 0; sp < 2; sp++) { \
          uint4 pk; \
          pk.x = pack2(sacc[kb][8 * sp + 0], sacc[kb][8 * sp + 1]); \
          pk.y = pack2(sacc[kb][8 * sp + 2], sacc[kb][8 * sp + 3]); \
          pk.z = pack2(sacc[kb][8 * sp + 4], sacc[kb][8 * sp + 5]); \
          pk.w = pack2(sacc[kb][8 * sp + 6], sacc[kb][8 * sp + 7]); \
          const bf16x8 pf = __builtin_bit_cast(bf16x8, pk); \
          _Pragma("unroll") for (int db = 0; db < 2; db++) { \
            const s16x4 lo = *(const s16x4*)&sm.vt[buf][db * 32 + r][kb * 32 + 16 * sp + 4 * h]; \
            const s16x4 hi = *(const s16x4*)&sm.vt[buf][db * 32 + r][kb * 32 + 16 * sp + 8 + 4 * h]; \
            const bf16x8 vf = __builtin_shufflevector(lo, hi, 0, 1, 2, 3, 4, 5, 6, 7); \
            oacc[db] = __builtin_amdgcn_mfma_f32_32x32x16_bf16(vf, pf, oacc[db], 0, 0, 0); \
          } \
        } \
    } while (0)
#define ATT_ITER(kt, SC, SN, par) do { \
    ATT_KSTASH((par) ^ 1); \
    ATT_VSTASH(par); \
    __syncthreads(); \
    ATT_KISSUE((kt) + 2); \
    ATT_VISSUE((kt) + 1); \
    if ((kt) + 1 < nkt && (((kt) + 1) << 6) <= qw + 31) ATT_S(SN, (par) ^ 1); \
    if (((kt) << 6) <= qw + 31) ATT_SMPV(SC, kt, par); \
  } while (0)
  f32x16 SA[2], SB[2];
  ATT_KISSUE(0);
  __syncthreads();
  ATT_KSTASH(0);
  __syncthreads();
  ATT_KISSUE(1);
  ATT_VISSUE(0);
  ATT_S(SA, 0);
#pragma unroll 1
  for (int kt = 0; kt < nkt; kt += 2) {
    ATT_ITER(kt, SA, SB, 0);
    ATT_ITER(kt + 1, SB, SA, 1);
  }
  const float l_tot = l_run + __shfl_xor(l_run, 32, 64);
  const float inv_l = 1.f / l_tot;
  const size_t t = (size_t)b * SEQ + qg;
#pragma unroll
  for (int db = 0; db < 2; db++)
#pragma unroll
    for (int gq = 0; gq < 4; gq++) {
      const int d = db * 32 + 8 * gq + 4 * h;
      const uint2 z = *(const uint2*)(SZB + t * 512 + hh * 64 + d);
      const float z0 = __uint_as_float(z.x << 16), z1 = __uint_as_float(z.x & 0xffff0000u);
      const float z2 = __uint_as_float(z.y << 16), z3 = __uint_as_float(z.y & 0xffff0000u);
      uint2 o;
      o.x = pack2(oacc[db][4 * gq + 0] * inv_l * z0, oacc[db][4 * gq + 1] * inv_l * z1);
      o.y = pack2(oacc[db][4 * gq + 2] * inv_l * z2, oacc[db][4 * gq + 3] * inv_l * z3);
      *(uint2*)(O + t * LDY + hh * 64 + d) = o;
    }
#endif
}

DI void phase4(const Params& p, Smem& sm, int* cnt, int mode = 0) {
  __shared__ int s_v;
  const unsigned xcc = xcc_id();
  if (threadIdx.x == 0) s_v = atomicExch(&cnt[64 + xcc * 256 + cu_key()], 1);
  __syncthreads();
  const bool scan_first = (s_v == 0);
  __syncthreads();
  if (scan_first && mode != 2) {
    if (threadIdx.x == 0) s_v = atomicAdd(&cnt[8], 1);
    __syncthreads();
    const int item = s_v;
    __syncthreads();
    if (item < 256) {
      __builtin_amdgcn_s_setprio(3);
      scan_item(p, item, sm.sc);
      __builtin_amdgcn_s_setprio(0);
    }
  }
  QState qs; qs.q = (int)xcc; qs.tried = 0;
  if (mode != 1) for (;;) {
    const int li = fetch_item(cnt, 256, qs);
    if (li < 0) break;
    attn_item(p, qs.q * 8 + (li >> 5), 31 - (li & 31), sm.at);
  }
  if (mode != 2) for (;;) {
    __syncthreads();
    if (threadIdx.x == 0) s_v = atomicAdd(&cnt[8], 1);
    __syncthreads();
    const int item = s_v;
    if (item >= 256) break;
    scan_item(p, item, sm.sc);
  }
}

DI void phase5(const Params& p) {
  const long gtid = (long)blockIdx.x * 256 + threadIdx.x, nth = (long)gridDim.x * 256;
  const int lane = threadIdx.x & 63, sub = lane >> 4, l16 = lane & 15;
  const long wave = gtid >> 6, nw = nth >> 6;
  char* ws = p.ws;
  const u16* FA = (const u16*)(ws + O_FA);
  const u16* SZA = (const u16*)(ws + O_SZA);
  const float* BONUS = (const float*)(ws + O_BONUS);
  u16* Y = (u16*)((char*)p.out + D_YA);
  for (long it = wave; it < (long)T * 2; it += nw) {
    const long item = it * 4 + sub;
    const long t = item >> 3;
    const int hh = (int)(item & 7), c = hh * 64 + l16 * 4;
    const int s = (int)(t & (SEQ - 1));
    const float4 y = ld4(Y + t * LDY + c);
    const float mean = row16_sum((y.x + y.y) + (y.z + y.w)) * (1.f / 64.f);
    const float d0 = y.x - mean, d1 = y.y - mean, d2 = y.z - mean, d3 = y.w - mean;
    const float var = row16_sum((d0 * d0 + d1 * d1) + (d2 * d2 + d3 * d3)) * (1.f / 64.f);
    const float rstd = rsqrtf(var + GN_EPS);
    const float4 gg = *(const float4*)(p.gn_g + c), gb = *(const float4*)(p.gn_b + c), mu = *(const float4*)(p.mu + 1024 + c);
    const float4 vf = ld4(FA + t * FAW + 1024 + c);
    float4 vp = ld4(FA + (s > 0 ? t - 1 : t) * FAW + 1024 + c);
    if (s == 0) vp = make_float4(0.f, 0.f, 0.f, 0.f);
    const float bon = BONUS[t * 8 + hh];
    const float4 z = ld4(SZA + t * 512 + c);
    float4 o;
    o.x = (d0 * rstd * gg.x + gb.x + bon * (vf.x + mu.x * (vp.x - vf.x))) * z.x;
    o.y = (d1 * rstd * gg.y + gb.y + bon * (vf.y + mu.y * (vp.y - vf.y))) * z.y;
    o.z = (d2 * rstd * gg.z + gb.z + bon * (vf.z + mu.z * (vp.z - vf.z))) * z.z;
    o.w = (d3 * rstd * gg.w + gb.w + bon * (vf.w + mu.w * (vp.w - vf.w))) * z.w;
    st4(Y + t * LDY + c, o);
  }
}

DI void phase6(const Params& p, Smem& sm, int* cnt) {
  char* ws = p.ws;
  const u16* YA = (const u16*)((char*)p.out + D_YA);
  const u16* O = (const u16*)((char*)p.out + D_O);
  const u16* G = (const u16*)(ws + O_G);
  u16* MG = (u16*)(ws + O_U);
  const int xcd = blockIdx.x & 7, lb = blockIdx.x >> 3, nlb = gridDim.x >> 3;
  for (int li = lb; li < 256; li += nlb) {
    const int mt = xcd * 32 + (li >> 3), nt = li & 7;
    f32x16 acc[2][2];
    acc_zero(acc);
    u32 pk1[2][2][8];
    gemm_tile_dual(YA, (const u16*)(ws + O_WOA), O, (const u16*)(ws + O_WOB), LDY, LDY, mt * 128, nt * 128, acc, pk1, sm.g);
    acc_epilogue2(pk1, acc, mt * 128, nt * 128, sm.g, [&](int row, int col, float4 va, float4 vb) {
      const float4 ga = ld4(G + (size_t)row * LDG + col);
      const float4 gb = ld4(G + (size_t)row * LDG + 1024 + col);
      st4(MG + (size_t)row * LDU + col, make_float4(va.x * ga.x + vb.x * gb.x, va.y * ga.y + vb.y * gb.y,
                                                   va.z * ga.z + vb.z * gb.z, va.w * ga.w + vb.w * gb.w));
    });
  }
}

DI void phase7(const Params& p, Smem& sm, int* cnt) {
  char* ws = p.ws;
  const u16* MG = (const u16*)(ws + O_U);
  u16* TP = (u16*)(ws + O_FA);
  const int xcd = blockIdx.x & 7, lb = blockIdx.x >> 3, nlb = gridDim.x >> 3;
  for (int li = lb; li < 256; li += nlb) {
    const int mt = xcd * 32 + (li >> 3), nt = li & 7;
    f32x16 acc[2][2];
    acc_zero(acc);
    gemm_tile_acc(MG, LDU, (const u16*)(ws + O_WO), LDU, 1024, mt * 128, nt * 128, acc, sm.g);
    acc_epilogue(acc, mt * 128, nt * 128, sm.g, [&](int row, int col, float4 v) { st4(TP + (size_t)row * LDU + col, v); });
  }
}

DI void phase8(const Params& p) {
  int bz;
  asm volatile("v_mov_b32 %0, 0" : "=v"(bz));
  const long gtid = (long)(blockIdx.x + bz) * 256 + threadIdx.x, nth = (long)gridDim.x * 256;
  const int lane = threadIdx.x & 63;
  const long wave = gtid >> 6, nw = nth >> 6;
  const u16* TP = (const u16*)(p.ws + O_FA);
  for (long row = wave; row < T; row += nw) {
    float v[16];
    float ss = 0.f;
#pragma unroll
    for (int i = 0; i < 2; i++) {
      const uint4 u = *(const uint4*)(TP + row * LDU + i * 512 + lane * 8);
      v[i * 8 + 0] = __uint_as_float(u.x << 16); v[i * 8 + 1] = __uint_as_float(u.x & 0xffff0000u);
      v[i * 8 + 2] = __uint_as_float(u.y << 16); v[i * 8 + 3] = __uint_as_float(u.y & 0xffff0000u);
      v[i * 8 + 4] = __uint_as_float(u.z << 16); v[i * 8 + 5] = __uint_as_float(u.z & 0xffff0000u);
      v[i * 8 + 6] = __uint_as_float(u.w << 16); v[i * 8 + 7] = __uint_as_float(u.w & 0xffff0000u);
    }
#pragma unroll
    for (int i = 0; i < 16; i++) ss += v[i] * v[i];
    ss = wave_sum(ss);
    const float rs = rsqrtf(ss * (1.f / 1024.f) + NORM_EPS);
#pragma unroll
    for (int i = 0; i < 4; i++) {
      const int c = (i >> 1) * 512 + lane * 8 + (i & 1) * 4;
      const float4 g = *(const float4*)(p.g_post + c);
      const float4 xx = *(const float4*)(p.x + row * 1024 + c);
      float4 o;
      o.x = xx.x + v[i * 4 + 0] * rs * g.x; o.y = xx.y + v[i * 4 + 1] * rs * g.y;
      o.z = xx.z + v[i * 4 + 2] * rs * g.z; o.w = xx.w + v[i * 4 + 3] * rs * g.w;
      *(float4*)(p.out + row * 1024 + c) = o;
    }
  }
}

__global__ void __launch_bounds__(256, 2) fwd_megakernel(Params p) {
  cg::grid_group grid = cg::this_grid();
  __shared__ Smem sm;
  int* cnt = (int*)(p.ws + O_CNT);
  GBar gb;
  gbar_init(gb, (unsigned*)(p.ws + O_CNT) + 12288);
  if (p.never) grid.sync();
#define GSYNC() gbar_sync(gb)
  phase0(p);
  GSYNC();
  if (PROBE == 0) { phase0(p); GSYNC(); }
  phase1(p, sm, cnt);
  GSYNC();
  if (PROBE == 1) { phase1(p, sm, cnt + 4096); GSYNC(); }
  phase2(p);
  GSYNC();
  if (PROBE == 2) { phase2(p); GSYNC(); }
  phase3(p, sm, cnt + 8);
  GSYNC();
  if (PROBE == 3) { phase3(p, sm, cnt + 4096); GSYNC(); }
  if (PROBE == 41) { phase4(p, sm, cnt + 4096, 1); GSYNC(); }
  if (PROBE == 42) { phase4(p, sm, cnt + 4096, 2); GSYNC(); }
  phase4(p, sm, cnt + 1024);
  GSYNC();
  if (PROBE == 4) { phase4(p, sm, cnt + 4096); GSYNC(); }
  phase5(p);
  GSYNC();
  phase6(p, sm, cnt + 16);
  GSYNC();
  if (PROBE == 6) { phase6(p, sm, cnt + 4096); GSYNC(); }
  phase7(p, sm, cnt + 24);
  GSYNC();
  if (PROBE == 7) { phase7(p, sm, cnt + 4096); GSYNC(); }
  if (PROBE == 80) { for (int rep = 0; rep < 8; rep++) GSYNC(); }
  phase8(p);
}

extern "C" void kernel_launch(void* const* d_in, const int* in_sizes, int n_in,
                              void* d_out, int out_size, void* d_ws, size_t ws_size,
                              hipStream_t stream) {
  static int grid_blocks = 0;
  if (!grid_blocks) {
    int dev = 0, cus = 0, per_cu = 0;
    hipGetDevice(&dev);
    hipDeviceGetAttribute(&cus, hipDeviceAttributeMultiprocessorCount, dev);
    hipOccupancyMaxActiveBlocksPerMultiprocessor(&per_cu, fwd_megakernel, 256, 0);
    if (per_cu > 2) per_cu = 2;
    if (per_cu < 1) per_cu = 1;
    grid_blocks = cus * per_cu;
  }
  if (ws_size < WS_NEED) { fprintf(stderr, "workspace too small: %zu < %zu\n", ws_size, (size_t)WS_NEED); return; }
  Params p{};
  p.x = (const float*)d_in[0]; p.pos = (const int*)d_in[1]; p.g_pre = (const float*)d_in[2]; p.w_in = (const float*)d_in[3];
  p.b_gate = (const float*)d_in[4]; p.mu = (const float*)d_in[5]; p.w0 = (const float*)d_in[6]; p.w_dec = (const float*)d_in[7];
  p.a0 = (const float*)d_in[8]; p.w_icl = (const float*)d_in[9]; p.k_k = (const float*)d_in[10]; p.k_a = (const float*)d_in[11];
  p.r_k = (const float*)d_in[12]; p.gn_g = (const float*)d_in[13]; p.gn_b = (const float*)d_in[14]; p.w_oa = (const float*)d_in[15];
  p.g_q = (const float*)d_in[16]; p.w_uq = (const float*)d_in[17]; p.g_kv = (const float*)d_in[18]; p.w_ukv = (const float*)d_in[19];
  p.w_ob = (const float*)d_in[20]; p.w_o = (const float*)d_in[21]; p.g_post = (const float*)d_in[22];
  p.out = (float*)d_out; p.ws = (char*)d_ws;
  p.never = 0;
  (void)hipMemsetAsync((char*)d_ws + O_CNT, 0, 65536, stream);
  void* args[] = {&p};
  hipError_t e = hipLaunchCooperativeKernel((void*)fwd_megakernel, dim3(grid_blocks), dim3(256), args, 0, stream);
  if (e != hipSuccess) fprintf(stderr, "cooperative launch failed: %s (grid %d)\n", hipGetErrorString(e), grid_blocks);
}
```

```cpp
#include <hip/hip_runtime.h>
#include <hip/hip_cooperative_groups.h>
#include <cstdio>
namespace cg = cooperative_groups;

#ifndef PROBE
#define PROBE -1
#endif
#ifndef NAIVE_GEMM
#define NAIVE_GEMM 0
#endif
#ifndef NAIVE_ATTN
#define NAIVE_ATTN 0
#endif

typedef unsigned short u16;
typedef unsigned int u32;
typedef __attribute__((ext_vector_type(8))) short bf16x8;
typedef __attribute__((ext_vector_type(4))) short s16x4;
typedef __attribute__((ext_vector_type(16))) float f32x16;
#define DI __device__ __forceinline__

constexpr int T = 32768, SEQ = 4096, NB = 8, DM = 1024;
constexpr int INC = 5152, INP = 5248;
constexpr int FAW = 1664;
constexpr int C_ZA = 1664, C_CQ = 2176, C_ZB = 2592, C_G = 3104;
constexpr int LDU = 1088, LDY = 576, LDG = 2112, LDV = 4160, LDQW = 320;
constexpr int CQW = 416;
constexpr float DECAY_SCALE = 0.6065306597f;
constexpr float GN_EPS = 64e-5f;
constexpr float NORM_EPS = 1e-6f;

constexpr size_t O_WIN = 0;
constexpr size_t O_WUQ = O_WIN + (size_t)INP * LDU * 2;
constexpr size_t O_WUKV = O_WUQ + 768 * LDQW * 2;
constexpr size_t O_WOA = O_WUKV + 1024 * 128 * 2;
constexpr size_t O_WOB = O_WOA + 1024 * LDY * 2;
constexpr size_t O_WO = O_WOB + 1024 * LDY * 2;
constexpr size_t O_WDEC = O_WO + 1024 * LDU * 2;
constexpr size_t O_WICL = O_WDEC + 512 * 64 * 2;
constexpr size_t O_RSQ = O_WICL + 512 * 64 * 2;
constexpr size_t O_RSKV = O_RSQ + (size_t)T * 4;
constexpr size_t O_BONUS = O_RSKV + (size_t)T * 4;
constexpr size_t O_CS = O_BONUS + (size_t)T * 8 * 4;
constexpr size_t O_CNT = O_CS + (size_t)T * 32 * 4;
constexpr size_t O_U = O_CNT + 65536;
constexpr size_t O_FA = O_U + (size_t)T * LDU * 2;
constexpr size_t O_SZA = O_FA + (size_t)T * FAW * 2;
constexpr size_t O_SZB = O_SZA + (size_t)T * 512 * 2;
constexpr size_t O_CQKV = O_SZB + (size_t)T * 512 * 2;
constexpr size_t O_G = O_CQKV + (size_t)T * CQW * 2;
constexpr size_t O_Q = O_G + (size_t)T * LDG * 2;
constexpr size_t O_K = O_Q + (size_t)T * 768 * 2;
constexpr size_t WS_NEED = O_K + (size_t)T * 768 * 2;
static_assert(WS_NEED <= (size_t)536870912, "workspace budget");
constexpr size_t D_YA = 0;
constexpr size_t D_O = D_YA + (size_t)T * LDY * 2;
constexpr size_t D_VT = D_O + (size_t)T * LDY * 2;
constexpr size_t D_LA = D_VT + (size_t)64 * 64 * LDV * 2;
static_assert(D_LA + (size_t)T * 128 * 2 <= (size_t)T * 1024 * 4, "d_out scratch budget");

struct Params {
  const float* x; const int* pos; const float* g_pre; const float* w_in; const float* b_gate; const float* mu;
  const float* w0; const float* w_dec; const float* a0; const float* w_icl; const float* k_k; const float* k_a;
  const float* r_k; const float* gn_g; const float* gn_b; const float* w_oa; const float* g_q; const float* w_uq;
  const float* g_kv; const float* w_ukv; const float* w_ob; const float* w_o; const float* g_post;
  float* out; char* ws; long never;
};

DI u16 f2bf(float x) { u32 u = __float_as_uint(x); u += 0x7fffu + ((u >> 16) & 1u); return (u16)(u >> 16); }
DI float bf2f(u16 b) { return __uint_as_float(((u32)b) << 16); }
typedef __attribute__((ext_vector_type(2))) float f32x2;
typedef __attribute__((ext_vector_type(2))) __bf16 bf16x2_t;
DI u32 pack2(float a, float b) { f32x2 v = {a, b}; bf16x2_t q = __builtin_convertvector(v, bf16x2_t); return __builtin_bit_cast(u32, q); }
DI void st4(u16* p, float4 v) { uint2 o; o.x = pack2(v.x, v.y); o.y = pack2(v.z, v.w); *(uint2*)p = o; }
DI float4 ld4(const u16* p) { const uint2 u = *(const uint2*)p; return make_float4(__uint_as_float(u.x << 16), __uint_as_float(u.x & 0xffff0000u), __uint_as_float(u.y << 16), __uint_as_float(u.y & 0xffff0000u)); }
DI float sigmoidf_(float x) { return __builtin_amdgcn_rcpf(1.f + __expf(-x)); }
DI float siluf_(float x) { return x * __builtin_amdgcn_rcpf(1.f + __expf(-x)); }
DI float wave_sum(float v) {
#pragma unroll
  for (int o = 32; o > 0; o >>= 1) v += __shfl_xor(v, o, 64);
  return v;
}
template <int CTRL> DI float dpp_mov(float x) {
  return __builtin_bit_cast(float, __builtin_amdgcn_update_dpp(0, __builtin_bit_cast(int, x), CTRL, 0xf, 0xf, true));
}
DI float row16_sum(float x) {
  x += dpp_mov<0xB1>(x);
  x += dpp_mov<0x4E>(x);
  x += dpp_mov<0x141>(x);
  x += dpp_mov<0x140>(x);
  return x;
}


DI unsigned xcc_id() { return (unsigned)__builtin_amdgcn_s_getreg((3 << 11) | 20) & 0x7u; }
DI unsigned cu_key() { return ((unsigned)__builtin_amdgcn_s_getreg(63492) >> 8) & 0xffu; }
struct QState { int q, tried; };
DI int fetch_item(int* cnt, int per_q, QState& st) {
  __shared__ int s_q, s_tr, s_it;
  __syncthreads();
  if (threadIdx.x == 0) {
    int qq = st.q, tr = st.tried, it = -1;
    while (tr < 8) {
      it = atomicAdd(&cnt[qq], 1);
      if (it < per_q) break;
      it = -1; qq = (qq + 1) & 7; tr++;
    }
    s_q = qq; s_tr = tr; s_it = it;
  }
  __syncthreads();
  st.q = s_q; st.tried = s_tr;
  return s_it;
}


#define XB_XCNT(j) (64 * (j))
#define XB_XSUB(j) (512 + 64 * (j))
#define XB_XGEN(j) (1024 + 64 * (j))
#define XB_TOP 1536
#define XB_TOPGEN 1600
DI unsigned xb_ld(unsigned* p) { return __hip_atomic_load(p, __ATOMIC_RELAXED, __HIP_MEMORY_SCOPE_AGENT); }
DI unsigned xb_add(unsigned* p, unsigned v) { return __hip_atomic_fetch_add(p, v, __ATOMIC_RELAXED, __HIP_MEMORY_SCOPE_AGENT); }
struct GBar { unsigned* bar; unsigned x, nloc, nx; };
DI void gbar_init(GBar& g, unsigned* bar) {
  g.bar = bar; g.x = xcc_id(); g.nloc = 0; g.nx = 0;
  if (threadIdx.x == 0) (void)xb_add(&bar[XB_XCNT(g.x)], 1u);
}
DI void gbar_sync(GBar& g) {
  asm volatile("s_waitcnt vmcnt(0)" ::: "memory");
  __syncthreads();
  if (threadIdx.x == 0) {
    unsigned* bar = g.bar;
    if (g.nloc == 0u) {
      unsigned sum, cnt, mine;
      for (;;) {
        sum = 0u; cnt = 0u; mine = 0u;
#pragma unroll
        for (unsigned j = 0; j < 8; ++j) { const unsigned c = xb_ld(&bar[XB_XCNT(j)]); sum += c; cnt += (c > 0u) ? 1u : 0u; mine = (j == g.x) ? c : mine; }
        if (sum == gridDim.x) break;
        __builtin_amdgcn_s_sleep(1);
      }
      g.nloc = mine; g.nx = cnt;
    }
    const unsigned old = xb_add(&bar[XB_XSUB(g.x)], 1u);
    const unsigned gen = old / g.nloc;
    if (old + 1u == (gen + 1u) * g.nloc) {
      __builtin_amdgcn_fence(__ATOMIC_RELEASE, "agent");
      asm volatile("s_waitcnt vmcnt(0)" ::: "memory");
      const unsigned og = xb_add(&bar[XB_TOP], 1u);
      const unsigned tg = og / g.nx;
      if (og + 1u == (tg + 1u) * g.nx) xb_add(&bar[XB_TOPGEN], 1u);
      else while (xb_ld(&bar[XB_TOPGEN]) == tg) __builtin_amdgcn_s_sleep(1);
      __builtin_amdgcn_fence(__ATOMIC_ACQUIRE, "agent");
      xb_add(&bar[XB_XGEN(g.x)], 1u);
      asm volatile("s_waitcnt vmcnt(0)" ::: "memory");
    } else {
      while (xb_ld(&bar[XB_XGEN(g.x)]) == gen) __builtin_amdgcn_s_sleep(1);
      __builtin_amdgcn_fence(__ATOMIC_ACQUIRE, "agent");
      asm volatile("s_waitcnt vmcnt(0)" ::: "memory");
    }
  }
  __syncthreads();
}

struct SmemGemm { u16 a[2][128][72]; u16 b[2][128][72]; };
struct SmemAttn { u16 k[2][64][104]; u16 vt[2][64][72]; };
struct SmemScan { float vec[2][16][5][64]; float v[2][16][16]; float yp[16][16][16]; };
union __attribute__((aligned(16))) Smem { SmemGemm g; SmemAttn at; SmemScan sc; };

typedef __attribute__((ext_vector_type(4))) unsigned int u32x4;
#define G_LOAD(R, k0) do { \
    R##a0 = *(const u32x4*)(Ap + (k0)); R##a1 = *(const u32x4*)(Ap + sa32 + (k0)); R##a2 = *(const u32x4*)(Ap + 2 * sa32 + (k0)); R##a3 = *(const u32x4*)(Ap + 3 * sa32 + (k0)); \
    R##b0 = *(const u32x4*)(Bp + (k0)); R##b1 = *(const u32x4*)(Bp + sb32 + (k0)); R##b2 = *(const u32x4*)(Bp + 2 * sb32 + (k0)); R##b3 = *(const u32x4*)(Bp + 3 * sb32 + (k0)); } while (0)
#define G_STORE(buf, R) do { \
    *(u32x4*)&sm.a[buf][lrow][lkc] = R##a0; *(u32x4*)&sm.a[buf][lrow + 32][lkc] = R##a1; *(u32x4*)&sm.a[buf][lrow + 64][lkc] = R##a2; *(u32x4*)&sm.a[buf][lrow + 96][lkc] = R##a3; \
    *(u32x4*)&sm.b[buf][lrow][lkc] = R##b0; *(u32x4*)&sm.b[buf][lrow + 32][lkc] = R##b1; *(u32x4*)&sm.b[buf][lrow + 64][lkc] = R##b2; *(u32x4*)&sm.b[buf][lrow + 96][lkc] = R##b3; } while (0)
#define G_COMPUTE_LOW(buf) do {     \
    _Pragma("unroll") for (int s = 0; s < 4; s++) { \
      bf16x8 af[2], bfr[2]; \
      _Pragma("unroll") for (int i = 0; i < 2; i++) af[i] = *(const bf16x8*)&sm.a[buf][wm * 64 + i * 32 + r][s * 16 + h * 8]; \
      _Pragma("unroll") for (int j = 0; j < 2; j++) bfr[j] = *(const bf16x8*)&sm.b[buf][wn * 64 + j * 32 + r][s * 16 + h * 8]; \
      _Pragma("unroll") for (int i = 0; i < 2; i++) \
        _Pragma("unroll") for (int j = 0; j < 2; j++) acc[i][j] = __builtin_amdgcn_mfma_f32_32x32x16_bf16(af[i], bfr[j], acc[i][j], 0, 0, 0); \
    } } while (0)
#define G_COMPUTE(buf) do { \
    if (VAR == 1) { G_COMPUTE_LOW(buf); break; } \
    _Pragma("unroll") for (int hs = 0; hs < 2; hs++) {     \
      bf16x8 af[2][2], bfr[2][2]; \
      _Pragma("unroll") for (int s = 0; s < 2; s++) { \
        _Pragma("unroll") for (int i = 0; i < 2; i++) af[s][i] = *(const bf16x8*)&sm.a[buf][wm * 64 + i * 32 + r][(hs * 2 + s) * 16 + h * 8]; \
        _Pragma("unroll") for (int j = 0; j < 2; j++) bfr[s][j] = *(const bf16x8*)&sm.b[buf][wn * 64 + j * 32 + r][(hs * 2 + s) * 16 + h * 8]; \
      } \
      __builtin_amdgcn_sched_barrier(0); \
      _Pragma("unroll") for (int s = 0; s < 2; s++) \
        _Pragma("unroll") for (int i = 0; i < 2; i++) \
          _Pragma("unroll") for (int j = 0; j < 2; j++) acc[i][j] = __builtin_amdgcn_mfma_f32_32x32x16_bf16(af[s][i], bfr[s][j], acc[i][j], 0, 0, 0); \
      __builtin_amdgcn_sched_barrier(0); \
    } \
  } while (0)
#define G_STEP(kt, bufc, bufn) do { \
    const int kl_ = ((kt) + 2 < nk) ? (kt) + 2 : nk - 1;     \
    G_COMPUTE(bufc); \
    G_STORE(bufn, R0); \
    G_LOAD(R0, kl_ << 6); \
    __syncthreads(); } while (0)

template <int VAR = 0> DI void gemm_tile_acc(const u16* __restrict__ A, int lda, const u16* __restrict__ Bt, int ldb, int K,
                      int m0, int n0, f32x16 (&acc)[2][2], SmemGemm& sm) {
  const int tid = threadIdx.x, lane = tid & 63, w = tid >> 6, wm = w >> 1, wn = w & 1, r = lane & 31, h = lane >> 5;
  const int lrow = tid >> 3, lkc = (tid & 7) * 8;
  const u16* Ap = A + (size_t)(m0 + lrow) * lda + lkc;
  const u16* Bp = Bt + (size_t)(n0 + lrow) * ldb + lkc;
  const size_t sa32 = (size_t)32 * lda, sb32 = (size_t)32 * ldb;
  const int nk = K >> 6;
  u32x4 R0a0, R0a1, R0a2, R0a3, R0b0, R0b1, R0b2, R0b3;
  G_LOAD(R0, 0);
  __syncthreads();
  G_STORE(0, R0);
  if (nk == 1) {
    __syncthreads();
    G_COMPUTE(0);
    __syncthreads();
    return;
  }
  G_LOAD(R0, 64);
  __syncthreads();
  __builtin_amdgcn_s_setprio(1);
#pragma unroll 1
  for (int kt = 0; kt < nk; kt += 2) {
    G_STEP(kt, 0, 1);
    G_STEP(kt + 1, 1, 0);
  }
  __builtin_amdgcn_s_setprio(0);
}

DI void gemm_tile_dual(const u16* __restrict__ A1, const u16* __restrict__ B1, const u16* __restrict__ A2, const u16* __restrict__ B2,
                       int lda, int ldb, int m0, int n0, f32x16 (&acc)[2][2], u32 (&pk1)[2][2][8], SmemGemm& sm) {
  constexpr int VAR = 1;
  const int tid = threadIdx.x, lane = tid & 63, w = tid >> 6, wm = w >> 1, wn = w & 1, r = lane & 31, h = lane >> 5;
  const int lrow = tid >> 3, lkc = (tid & 7) * 8;
  const u16* A1p = A1 + (size_t)(m0 + lrow) * lda + lkc;
  const u16* B1p = B1 + (size_t)(n0 + lrow) * ldb + lkc;
  const u16* A2p = A2 + (size_t)(m0 + lrow) * lda + lkc;
  const u16* B2p = B2 + (size_t)(n0 + lrow) * ldb + lkc;
  const size_t sa32 = (size_t)32 * lda, sb32 = (size_t)32 * ldb;
  constexpr int nk = 16;
  u32x4 R0a0, R0a1, R0a2, R0a3, R0b0, R0b1, R0b2, R0b3;
#define GD_LOAD(kl) do { const int kl_ = (kl) < nk ? (kl) : nk - 1; \
    const u16* Ap = (kl_ < 8) ? A1p : A2p; const u16* Bp = (kl_ < 8) ? B1p : B2p; G_LOAD(R0, (kl_ & 7) << 6); } while (0)
#define GD_STEP(kt, bufc, bufn) do { G_COMPUTE(bufc); G_STORE(bufn, R0); GD_LOAD((kt) + 2); __syncthreads(); } while (0)
  GD_LOAD(0);
  __syncthreads();
  G_STORE(0, R0);
  GD_LOAD(1);
  __syncthreads();
  __builtin_amdgcn_s_setprio(1);
#pragma unroll 1
  for (int kt = 0; kt < nk; kt += 2) {
    if (kt == 8) {
#pragma unroll
      for (int i = 0; i < 2; i++)
#pragma unroll
        for (int j = 0; j < 2; j++) {
#pragma unroll
          for (int q = 0; q < 8; q++) pk1[i][j][q] = pack2(acc[i][j][2 * q], acc[i][j][2 * q + 1]);
#pragma unroll
          for (int g = 0; g < 16; g++) acc[i][j][g] = 0.f;
        }
    }
    GD_STEP(kt, 0, 1);
    GD_STEP(kt + 1, 1, 0);
  }
  __builtin_amdgcn_s_setprio(0);
}

DI void acc_zero(f32x16 (&acc)[2][2]) {
#pragma unroll
  for (int i = 0; i < 2; i++)
#pragma unroll
    for (int j = 0; j < 2; j++)
#pragma unroll
      for (int g = 0; g < 16; g++) acc[i][j][g] = 0.f;
}

DI void acc_stage(f32x16 (&acc)[2][2], SmemGemm& sm) {
  const int lane = threadIdx.x & 63, w = threadIdx.x >> 6, r = lane & 31, h = lane >> 5;
  float* wb = (float*)&sm + w * (64 * 68);
#pragma unroll
  for (int i = 0; i < 2; i++)
#pragma unroll
    for (int j = 0; j < 2; j++)
#pragma unroll
      for (int g = 0; g < 16; g++)
        wb[(i * 32 + (g & 3) + 8 * (g >> 2) + 4 * h) * 68 + j * 32 + r] = acc[i][j][g];
  __syncthreads();
}
template <class F> DI void acc_drain(int m0, int n0, SmemGemm& sm, F f) {
  const int lane = threadIdx.x & 63, w = threadIdx.x >> 6, wm = w >> 1, wn = w & 1;
  const float* wb = (const float*)&sm + w * (64 * 68);
  const int rl = lane >> 4, c4 = (lane & 15) * 4;
#pragma unroll 4
  for (int it = 0; it < 16; it++) {
    const int row_l = it * 4 + rl;
    const float4 v = *(const float4*)&wb[row_l * 68 + c4];
    f(m0 + wm * 64 + row_l, n0 + wn * 64 + c4, v);
  }
}
template <class F> DI void acc_epilogue(f32x16 (&acc)[2][2], int m0, int n0, SmemGemm& sm, F f) {
  acc_stage(acc, sm);
  acc_drain(m0, n0, sm, f);
}

template <class L, class F> DI void acc_epilogue2(const u32 (&pk1)[2][2][8], f32x16 (&acc2)[2][2], int m0, int n0, SmemGemm& sm, L ldg, F f) {
  const int lane = threadIdx.x & 63, w = threadIdx.x >> 6, wm = w >> 1, wn = w & 1, r = lane & 31, h = lane >> 5;
  float* wb = (float*)&sm + w * (64 * 68);
  const int rl = lane >> 4, c4 = (lane & 15) * 4;
  int lz;
  asm volatile("v_mov_b32 %0, 0" : "=v"(lz));
  m0 += lz;
  uint2 v1[16];
#pragma unroll
  for (int i = 0; i < 2; i++)
#pragma unroll
    for (int j = 0; j < 2; j++)
#pragma unroll
      for (int q = 0; q < 8; q++) {
        const int g0 = 2 * q, g1 = 2 * q + 1;
        wb[(i * 32 + (g0 & 3) + 8 * (g0 >> 2) + 4 * h) * 68 + j * 32 + r] = __uint_as_float(pk1[i][j][q] << 16);
        wb[(i * 32 + (g1 & 3) + 8 * (g1 >> 2) + 4 * h) * 68 + j * 32 + r] = __uint_as_float(pk1[i][j][q] & 0xffff0000u);
      }
  __syncthreads();
#pragma unroll
  for (int it = 0; it < 16; it++) {
    const float4 t = *(const float4*)&wb[(it * 4 + rl) * 68 + c4];
    v1[it] = make_uint2(pack2(t.x, t.y), pack2(t.z, t.w));
  }
  __syncthreads();
#pragma unroll
  for (int i = 0; i < 2; i++)
#pragma unroll
    for (int j = 0; j < 2; j++)
#pragma unroll
      for (int g = 0; g < 16; g++)
        wb[(i * 32 + (g & 3) + 8 * (g >> 2) + 4 * h) * 68 + j * 32 + r] = acc2[i][j][g];
  __syncthreads();
#pragma unroll
  for (int g4 = 0; g4 < 4; g4++) {
    uint4 gl[4];
#pragma unroll
    for (int k = 0; k < 4; k++) gl[k] = ldg(m0 + wm * 64 + (g4 * 4 + k) * 4 + rl, n0 + wn * 64 + c4);
#pragma unroll
    for (int k = 0; k < 4; k++) {
      const int it = g4 * 4 + k, row_l = it * 4 + rl;
      const float4 v2 = *(const float4*)&wb[row_l * 68 + c4];
      const float4 va = make_float4(__uint_as_float(v1[it].x << 16), __uint_as_float(v1[it].x & 0xffff0000u),
                                    __uint_as_float(v1[it].y << 16), __uint_as_float(v1[it].y & 0xffff0000u));
      f(m0 + wm * 64 + row_l, n0 + wn * 64 + c4, va, v2, gl[k]);
    }
  }
}

DI float4 silu4(float4 v) { return make_float4(siluf_(v.x), siluf_(v.y), siluf_(v.z), siluf_(v.w)); }
DI float4 sigm4(float4 v) { return make_float4(sigmoidf_(v.x), sigmoidf_(v.y), sigmoidf_(v.z), sigmoidf_(v.w)); }

DI void transpose_cvt(const float* __restrict__ src, int K, int N, u16* __restrict__ dst, int ldd, const float* __restrict__ kscale,
                      long gtid, long nth) {
  const long tot = (long)(K >> 3) * N;
  for (long idx = gtid; idx < tot; idx += nth) {
    const int kb = (int)(idx / N), n = (int)(idx - (long)kb * N), k0 = kb * 8;
    float v[8];
#pragma unroll
    for (int j = 0; j < 8; j++) v[j] = src[(size_t)(k0 + j) * N + n];
    if (kscale) {
#pragma unroll
      for (int j = 0; j < 8; j++) v[j] *= kscale[k0 + j];
    }
    uint4 o;
    o.x = pack2(v[0], v[1]); o.y = pack2(v[2], v[3]); o.z = pack2(v[4], v[5]); o.w = pack2(v[6], v[7]);
    *(uint4*)(dst + (size_t)n * ldd + k0) = o;
  }
}

DI void phase0(const Params& p) {
  const long gtid = (long)blockIdx.x * 256 + threadIdx.x, nth = (long)gridDim.x * 256;
  char* ws = p.ws;
  transpose_cvt(p.w_in, 1024, INC, (u16*)(ws + O_WIN), LDU, nullptr, gtid, nth);
  for (long idx = gtid; idx < (long)(INP - INC) * LDU; idx += nth) ((u16*)(ws + O_WIN))[(size_t)INC * LDU + idx] = 0;
  transpose_cvt(p.w_uq, 256, 768, (u16*)(ws + O_WUQ), LDQW, p.g_q, gtid, nth);
  transpose_cvt(p.w_ukv, 128, 1024, (u16*)(ws + O_WUKV), 128, p.g_kv, gtid, nth);
  transpose_cvt(p.w_oa, 512, 1024, (u16*)(ws + O_WOA), LDY, nullptr, gtid, nth);
  transpose_cvt(p.w_ob, 512, 1024, (u16*)(ws + O_WOB), LDY, nullptr, gtid, nth);
  transpose_cvt(p.w_o, 1024, 1024, (u16*)(ws + O_WO), LDU, nullptr, gtid, nth);
  transpose_cvt(p.w_dec, 64, 512, (u16*)(ws + O_WDEC), 64, nullptr, gtid, nth);
  transpose_cvt(p.w_icl, 64, 512, (u16*)(ws + O_WICL), 64, nullptr, gtid, nth);

  const int lane = threadIdx.x & 63;
  const long wave = gtid >> 6, nw = nth >> 6;
  u16* U = (u16*)(ws + O_U);
  for (long row = wave; row < T; row += nw) {
    const float4* xr = (const float4*)(p.x + row * 1024);
    float4 v[4];
    float ss = 0.f;
#pragma unroll
    for (int i = 0; i < 4; i++) { v[i] = xr[lane + 64 * i]; ss += v[i].x * v[i].x + v[i].y * v[i].y + v[i].z * v[i].z + v[i].w * v[i].w; }
    ss = wave_sum(ss);
    const float rs = rsqrtf(ss * (1.f / 1024.f) + NORM_EPS);
#pragma unroll
    for (int i = 0; i < 4; i++) {
      float4 g = ((const float4*)p.g_pre)[lane + 64 * i];
      uint2 o;
      o.x = pack2(v[i].x * rs * g.x, v[i].y * rs * g.y);
      o.y = pack2(v[i].z * rs * g.z, v[i].w * rs * g.w);
      *(uint2*)(U + row * LDU + (lane + 64 * i) * 4) = o;
    }
  }
}

DI void phase1(const Params& p, Smem& sm, int* cnt) {
  char* ws = p.ws;
  const u16* U = (const u16*)(ws + O_U);
  const u16* W = (const u16*)(ws + O_WIN);
  u16* FA = (u16*)(ws + O_FA); u16* SZA = (u16*)(ws + O_SZA); u16* SZB = (u16*)(ws + O_SZB);
  u16* CQKV = (u16*)(ws + O_CQKV); u16* G = (u16*)(ws + O_G);
  const float* bg = p.b_gate;
  const int xcd = blockIdx.x & 7, lb = blockIdx.x >> 3, nlb = gridDim.x >> 3;
  for (int li = lb; li < 32 * 41; li += nlb) {
    const int g = li / 328, rem = li - g * 328, nt = rem >> 3, mt = xcd * 32 + g * 8 + (rem & 7);
    f32x16 acc[2][2];
    acc_zero(acc);
    gemm_tile_acc(U, LDU, W, LDU, 1024, mt * 128, nt * 128, acc, sm.g);
    acc_stage(acc, sm.g);
    const int cw = __builtin_amdgcn_readfirstlane(nt * 128 + ((threadIdx.x >> 6) & 1) * 64);
    const int m0 = mt * 128, n0 = nt * 128;
    if (cw + 64 <= C_ZA) {
      acc_drain(m0, n0, sm.g, [&](int row, int col, float4 v) { st4(FA + (size_t)row * FAW + col, v); });
    } else if (cw >= C_ZA && cw + 64 <= C_CQ) {
      acc_drain(m0, n0, sm.g, [&](int row, int col, float4 v) { st4(SZA + (size_t)row * 512 + (col - C_ZA), silu4(v)); });
    } else if (cw >= C_ZB && cw + 64 <= C_G) {
      acc_drain(m0, n0, sm.g, [&](int row, int col, float4 v) { st4(SZB + (size_t)row * 512 + (col - C_ZB), silu4(v)); });
    } else if (cw >= C_G && cw + 64 <= INC) {
      const float4 bb = *(const float4*)(bg + (n0 + ((threadIdx.x >> 6) & 1) * 64 + (threadIdx.x & 15) * 4 - C_G));
      acc_drain(m0, n0, sm.g, [&](int row, int col, float4 v) {
        st4(G + (size_t)row * LDG + (col - C_G), sigm4(make_float4(v.x + bb.x, v.y + bb.y, v.z + bb.z, v.w + bb.w)));
      });
    } else {
      acc_drain(m0, n0, sm.g, [&](int row, int col, float4 v) {
        if (col < C_ZA) st4(FA + (size_t)row * FAW + col, v);
        else if (col < C_CQ) st4(SZA + (size_t)row * 512 + (col - C_ZA), silu4(v));
        else if (col < C_ZB) st4(CQKV + (size_t)row * CQW + (col - C_CQ), v);
        else if (col < C_G) st4(SZB + (size_t)row * 512 + (col - C_ZB), silu4(v));
        else if (col < INC) {
          const float4 bb = *(const float4*)(bg + (col - C_G));
          st4(G + (size_t)row * LDG + (col - C_G), sigm4(make_float4(v.x + bb.x, v.y + bb.y, v.z + bb.z, v.w + bb.w)));
        }
      });
    }
  }
}

DI void phase2(const Params& p) {
  const long gtid = (long)blockIdx.x * 256 + threadIdx.x, nth = (long)gridDim.x * 256;
  const int lane = threadIdx.x & 63, sub = lane >> 4, l16 = lane & 15;
  const long wave = gtid >> 6, nw = nth >> 6;
  char* ws = p.ws;
  const u16* FA = (const u16*)(ws + O_FA);
  const u16* CQKV = (const u16*)(ws + O_CQKV);
  u16* LA = (u16*)((char*)p.out + D_LA);
  u16* Kb = (u16*)(ws + O_K);
  float* RSQ = (float*)(ws + O_RSQ); float* RSKV = (float*)(ws + O_RSKV);
  float* CS = (float*)(ws + O_CS);
  const float4 mu_wd = *(const float4*)(p.mu + 1536 + l16 * 4), mu_ad = *(const float4*)(p.mu + 1600 + l16 * 4);
  const float inv_freq = powf(10000.0f, -(float)l16 / 16.0f);
  for (long it = wave; it < T / 4; it += nw) {
    const long t = it * 4 + sub;
    const int s = (int)(t & (SEQ - 1)), b = (int)(t >> 12);
    const u16* fa = FA + t * FAW;
    const u16* fp = (s > 0) ? fa - FAW : fa;
    {
      const float4 f = ld4(fa + 1536 + l16 * 4);
      float4 pv = ld4(fp + 1536 + l16 * 4);
      if (s == 0) pv = make_float4(0.f, 0.f, 0.f, 0.f);
      st4(LA + t * 128 + l16 * 4, make_float4(tanhf(f.x + mu_wd.x * (pv.x - f.x)), tanhf(f.y + mu_wd.y * (pv.y - f.y)),
                                              tanhf(f.z + mu_wd.z * (pv.z - f.z)), tanhf(f.w + mu_wd.w * (pv.w - f.w))));
      const float4 f2 = ld4(fa + 1600 + l16 * 4);
      float4 pv2 = ld4(fp + 1600 + l16 * 4);
      if (s == 0) pv2 = make_float4(0.f, 0.f, 0.f, 0.f);
      st4(LA + t * 128 + 64 + l16 * 4, make_float4(f2.x + mu_ad.x * (pv2.x - f2.x), f2.y + mu_ad.y * (pv2.y - f2.y),
                                                   f2.z + mu_ad.z * (pv2.z - f2.z), f2.w + mu_ad.w * (pv2.w - f2.w)));
    }
    const u16* c = CQKV + t * CQW;
    float ss = 0.f, ss2 = 0.f;
#pragma unroll
    for (int i = 0; i < 4; i++) { const float4 v = ld4(c + i * 64 + l16 * 4); ss += (v.x * v.x + v.y * v.y) + (v.z * v.z + v.w * v.w); }
#pragma unroll
    for (int i = 0; i < 2; i++) { const float4 v = ld4(c + 256 + i * 64 + l16 * 4); ss2 += (v.x * v.x + v.y * v.y) + (v.z * v.z + v.w * v.w); }
    ss = row16_sum(ss);
    ss2 = row16_sum(ss2);
    if (l16 == 0) {
      RSQ[t] = rsqrtf(ss * (1.f / 256.f) + NORM_EPS);
      RSKV[t] = rsqrtf(ss2 * (1.f / 128.f) + NORM_EPS);
    }
    {
      const float t1 = bf2f(c[384 + l16]), t2 = bf2f(c[400 + l16]);
      const float ang = (float)p.pos[t] * inv_freq;
      const float cs = cosf(ang), sn = sinf(ang);
      CS[t * 32 + l16] = cs;
      CS[t * 32 + 16 + l16] = sn;
      const u16 o1 = f2bf(t1 * cs - t2 * sn), o2 = f2bf(t2 * cs + t1 * sn);
#pragma unroll
      for (int hh = 0; hh < 8; hh++) {
        const size_t base = ((size_t)(b * 8 + hh) * SEQ + s) * 96 + 64;
        Kb[base + l16] = o1;
        Kb[base + 16 + l16] = o2;
      }
    }
  }
}

DI void kv_epilogue(f32x16 (&acc)[2][2], int m0, int hh, SmemGemm& sm, const float* __restrict__ RSKV, u16* __restrict__ Kb, u16* __restrict__ Vt) {
  const int lane = threadIdx.x & 63, w = threadIdx.x >> 6, wm = w >> 1, wn = w & 1, r = lane & 31, h = lane >> 5;
  float* wb = (float*)&sm + w * (64 * 68);
#pragma unroll
  for (int i = 0; i < 2; i++)
#pragma unroll
    for (int j = 0; j < 2; j++)
#pragma unroll
      for (int g = 0; g < 16; g++)
        wb[(i * 32 + (g & 3) + 8 * (g >> 2) + 4 * h) * 68 + j * 32 + r] = acc[i][j][g];
  __syncthreads();
  const int row0 = m0 + wm * 64, b = row0 >> 12, s0 = row0 & (SEQ - 1);
  if (wn == 0) {
    const int rl = lane >> 4, c4 = (lane & 15) * 4;
#pragma unroll 4
    for (int it = 0; it < 16; it++) {
      const int row_l = it * 4 + rl;
      float4 v = *(const float4*)&wb[row_l * 68 + c4];
      const float rs = RSKV[row0 + row_l];
      v.x *= rs; v.y *= rs; v.z *= rs; v.w *= rs;
      st4(Kb + ((size_t)(b * 8 + hh) * SEQ + s0 + row_l) * 96 + c4, v);
    }
  } else {
    u16* vp = Vt + ((size_t)(b * 8 + hh) * 64 + lane) * LDV + s0;
#pragma unroll 4
    for (int rg = 0; rg < 16; rg++) {
      const float4 rs = *(const float4*)(RSKV + row0 + rg * 4);
      float4 v;
      v.x = wb[(rg * 4 + 0) * 68 + lane] * rs.x; v.y = wb[(rg * 4 + 1) * 68 + lane] * rs.y;
      v.z = wb[(rg * 4 + 2) * 68 + lane] * rs.z; v.w = wb[(rg * 4 + 3) * 68 + lane] * rs.w;
      st4(vp + rg * 4, v);
    }
  }
}

DI void phase3(const Params& p, Smem& sm, int* cnt) {
  char* ws = p.ws;
  const u16* LA = (const u16*)((char*)p.out + D_LA);
  const u16* CQKV = (const u16*)(ws + O_CQKV);
  u16* NLW = (u16*)(ws + O_U);
  u16* Ab = (u16*)(ws + O_U + (size_t)T * 512 * 2);
  u16* Qb = (u16*)(ws + O_Q);
  u16* Kb = (u16*)(ws + O_K);
  u16* Vt = (u16*)((char*)p.out + D_VT);
  const float* RSQ = (const float*)(ws + O_RSQ);
  const float* RSKV = (const float*)(ws + O_RSKV);
  const float* CS = (const float*)(ws + O_CS);
  const float qscale = 1.4426950408889634f * 0.10206207261596575f;
  const int n_dec = 32 * 4, n_icl = 32 * 4, n_q = 32 * 6, n_kv = 32 * 8;
  const int xcd = blockIdx.x & 7, lb = blockIdx.x >> 3, nlb = gridDim.x >> 3;
  for (int li = lb; li < n_dec + n_icl + n_q + n_kv; li += nlb) {
    f32x16 acc[2][2];
    acc_zero(acc);
    if (li < n_dec) {
      const int mt = xcd * 32 + (li >> 2), nt = li & 3;
      gemm_tile_acc(LA, 128, (const u16*)(ws + O_WDEC), 64, 64, mt * 128, nt * 128, acc, sm.g);
      const float* w0 = p.w0;
      const float4 ww = *(const float4*)(w0 + nt * 128 + ((threadIdx.x >> 6) & 1) * 64 + (threadIdx.x & 15) * 4);
      acc_epilogue(acc, mt * 128, nt * 128, sm.g, [&](int row, int col, float4 v) {
        st4(NLW + (size_t)row * 512 + col, make_float4(1.f - __expf(-DECAY_SCALE * sigmoidf_(ww.x + v.x)), 1.f - __expf(-DECAY_SCALE * sigmoidf_(ww.y + v.y)),
                                                       1.f - __expf(-DECAY_SCALE * sigmoidf_(ww.z + v.z)), 1.f - __expf(-DECAY_SCALE * sigmoidf_(ww.w + v.w))));
      });
    } else if (li < n_dec + n_icl) {
      const int tt = li - n_dec, mt = xcd * 32 + (tt >> 2), nt = tt & 3;
      gemm_tile_acc(LA + 64, 128, (const u16*)(ws + O_WICL), 64, 64, mt * 128, nt * 128, acc, sm.g);
      const float* a0 = p.a0;
      const float4 aa = *(const float4*)(a0 + nt * 128 + ((threadIdx.x >> 6) & 1) * 64 + (threadIdx.x & 15) * 4);
      acc_epilogue(acc, mt * 128, nt * 128, sm.g, [&](int row, int col, float4 v) {
        st4(Ab + (size_t)row * 512 + col, sigm4(make_float4(aa.x + v.x, aa.y + v.y, aa.z + v.z, aa.w + v.w)));
      });
    } else if (li < n_dec + n_icl + n_q) {
      const int tt = li - n_dec - n_icl, ml = tt / 6, nt = tt - ml * 6, mt = xcd * 32 + ml;
      gemm_tile_acc(CQKV, CQW, (const u16*)(ws + O_WUQ), LDQW, 256, mt * 128, nt * 128, acc, sm.g);
      acc_epilogue(acc, mt * 128, nt * 128, sm.g, [&](int row, int col, float4 v) {
        const int hh = col / 96, d = col - hh * 96, b = row >> 12, s = row & (SEQ - 1);
        const float rs = RSQ[row] * qscale;
        v.x *= rs; v.y *= rs; v.z *= rs; v.w *= rs;
        float4 pv;
        {
          const bool up = (d < 80);
          const float ax = dpp_mov<0x104>(v.x), bx = dpp_mov<0x114>(v.x);
          const float ay = dpp_mov<0x104>(v.y), by = dpp_mov<0x114>(v.y);
          const float az = dpp_mov<0x104>(v.z), bz = dpp_mov<0x114>(v.z);
          const float aw = dpp_mov<0x104>(v.w), bw = dpp_mov<0x114>(v.w);
          pv.x = up ? ax : bx; pv.y = up ? ay : by; pv.z = up ? az : bz; pv.w = up ? aw : bw;
        }
        if (d >= 64) {
          const int i = (d - 64) & 15;
          const float4 cs = *(const float4*)(CS + (size_t)row * 32 + i);
          const float4 sn = *(const float4*)(CS + (size_t)row * 32 + 16 + i);
          const float sg = (d < 80) ? -1.f : 1.f;
          v.x = v.x * cs.x + sg * pv.x * sn.x; v.y = v.y * cs.y + sg * pv.y * sn.y;
          v.z = v.z * cs.z + sg * pv.z * sn.z; v.w = v.w * cs.w + sg * pv.w * sn.w;
        }
        st4(Qb + ((size_t)(b * 8 + hh) * SEQ + s) * 96 + d, v);
      });
    } else {
      const int tt = li - n_dec - n_icl - n_q, mt = xcd * 32 + (tt >> 3), nt = tt & 7;
      gemm_tile_acc(CQKV + 256, CQW, (const u16*)(ws + O_WUKV), 128, 128, mt * 128, nt * 128, acc, sm.g);
      kv_epilogue(acc, mt * 128, nt, sm.g, RSKV, Kb, Vt);
    }
  }
}

DI void scan_item(const Params& p, int item, SmemScan& sm) {
  const int tid = threadIdx.x, lane = tid & 63, w = tid >> 6;
  const int vg = item & 3, bh = item >> 2, hh = bh & 7, b = bh >> 3;
  char* ws = p.ws;
  const u16* FA = (const u16*)(ws + O_FA);
  const u16* NLW = (const u16*)(ws + O_U);
  const u16* Ab = (const u16*)(ws + O_U + (size_t)T * 512 * 2);
  float* BONUS = (float*)(ws + O_BONUS);
  u16* Y = (u16*)((char*)p.out + D_YA);
  const int st = tid >> 4, kq = tid & 15, col = hh * 64 + kq * 4;
  float mu_r[4], mu_k[4], mu_v[4], ckk[4], cka[4], crk[4], omc[4];
#pragma unroll
  for (int i = 0; i < 4; i++) {
    mu_r[i] = p.mu[col + i]; mu_k[i] = p.mu[512 + col + i]; mu_v[i] = p.mu[1024 + col + i];
    ckk[i] = p.k_k[col + i]; cka[i] = p.k_a[col + i]; crk[i] = p.r_k[col + i]; omc[i] = 1.f - cka[i];
  }
  struct SIn { uint2 rf, rp, kf, kp, vf, vp, a, w; };
  auto issue = [&](int tc, SIn& g) {
    const int s = tc + st;
    const size_t t = (size_t)b * SEQ + s;
    const u16* fa = FA + t * FAW + col;
    const u16* fp = (s > 0) ? fa - FAW : fa;
    g.rf = *(const uint2*)(fa);
    g.kf = *(const uint2*)(fa + 512);
    g.vf = *(const uint2*)(fa + 1024);
    g.rp = *(const uint2*)(fp);
    g.kp = *(const uint2*)(fp + 512);
    g.vp = *(const uint2*)(fp + 1024);
    g.a = *(const uint2*)(Ab + t * 512 + col);
    g.w = *(const uint2*)(NLW + t * 512 + col);
  };
  auto unp = [](uint2 u, float (&f)[4]) {
    f[0] = __uint_as_float(u.x << 16); f[1] = __uint_as_float(u.x & 0xffff0000u);
    f[2] = __uint_as_float(u.y << 16); f[3] = __uint_as_float(u.y & 0xffff0000u);
  };
  auto process = [&](int tc, const SIn& g, int pb) {
    float rf[4], rp[4], kf[4], kp[4], vf[4], vp[4], av[4], nl[4];
    unp(g.rf, rf); unp(g.rp, rp); unp(g.kf, kf); unp(g.kp, kp); unp(g.vf, vf); unp(g.vp, vp); unp(g.a, av); unp(g.w, nl);
    if (tc + st == 0) {
#pragma unroll
      for (int i = 0; i < 4; i++) { rp[i] = 0.f; kp[i] = 0.f; vp[i] = 0.f; }
    }
    float rr[4], ks[4], vs[4], kkr[4];
    float n2 = 0.f, bon = 0.f;
#pragma unroll
    for (int i = 0; i < 4; i++) {
      rr[i] = rf[i] + mu_r[i] * (rp[i] - rf[i]);
      ks[i] = kf[i] + mu_k[i] * (kp[i] - kf[i]);
      vs[i] = vf[i] + mu_v[i] * (vp[i] - vf[i]);
      kkr[i] = ks[i] * ckk[i];
      n2 += kkr[i] * kkr[i];
    }
    n2 = row16_sum(n2);
    const float inv = __builtin_amdgcn_rsqf(fmaxf(n2, 1e-24f));
    float4 o_w, o_kk, o_b, o_kx, o_r;
    float kx[4], kk[4];
#pragma unroll
    for (int i = 0; i < 4; i++) {
      kk[i] = kkr[i] * inv;
      kx[i] = ks[i] * (av[i] * cka[i] + omc[i]);
      bon += rr[i] * kx[i] * crk[i];
    }
    bon = row16_sum(bon);
    o_w = make_float4(1.f - nl[0], 1.f - nl[1], 1.f - nl[2], 1.f - nl[3]);
    o_kk = make_float4(kk[0], kk[1], kk[2], kk[3]);
    o_b = make_float4(kk[0] * av[0], kk[1] * av[1], kk[2] * av[2], kk[3] * av[3]);
    o_kx = make_float4(kx[0], kx[1], kx[2], kx[3]);
    o_r = make_float4(rr[0], rr[1], rr[2], rr[3]);
    *(float4*)&sm.vec[pb][st][0][kq * 4] = o_w;
    *(float4*)&sm.vec[pb][st][1][kq * 4] = o_kk;
    *(float4*)&sm.vec[pb][st][2][kq * 4] = o_b;
    *(float4*)&sm.vec[pb][st][3][kq * 4] = o_kx;
    *(float4*)&sm.vec[pb][st][4][kq * 4] = o_r;
    if ((kq >> 2) == vg) *(float4*)&sm.v[pb][st][(kq & 3) * 4] = make_float4(vs[0], vs[1], vs[2], vs[3]);
    if (vg == 0 && kq == 0) BONUS[((size_t)b * SEQ + tc + st) * 8 + hh] = bon;
  };
  const int vl = lane >> 4, kg = lane & 15;
  const int rowb = w * 4 + vl;
  f32x2 S01 = {0.f, 0.f}, S23 = {0.f, 0.f};
  const int ys = lane >> 2, yr = w * 4 + (lane & 3);
  SIn gA, gB;
  issue(0, gA);
  issue(16, gB);
  __syncthreads();
  process(0, gA, 0);
  __syncthreads();
#define LO2(v) (f32x2{(v).x, (v).y})
#define HI2(v) (f32x2{(v).z, (v).w})
#define SCAN_CHUNK(tc_, gfree, gnext, cb) do { \
    process(((tc_) + 16 < SEQ) ? (tc_) + 16 : SEQ - 16, gnext, (cb) ^ 1); \
    issue(((tc_) + 32 < SEQ) ? (tc_) + 32 : SEQ - 16, gfree); \
    float4 w4 = *(const float4*)&sm.vec[cb][0][0][kg * 4]; \
    float4 kk4 = *(const float4*)&sm.vec[cb][0][1][kg * 4]; \
    float4 b4 = *(const float4*)&sm.vec[cb][0][2][kg * 4]; \
    float4 kx4 = *(const float4*)&sm.vec[cb][0][3][kg * 4]; \
    float4 r4 = *(const float4*)&sm.vec[cb][0][4][kg * 4]; \
    float vv = sm.v[cb][0][rowb]; \
    _Pragma("unroll") for (int s = 0; s < 16; s++) { \
      const int sn = (s < 15) ? s + 1 : 15; \
      const float4 nw4 = *(const float4*)&sm.vec[cb][sn][0][kg * 4]; \
      const float4 nkk4 = *(const float4*)&sm.vec[cb][sn][1][kg * 4]; \
      const float4 nb4 = *(const float4*)&sm.vec[cb][sn][2][kg * 4]; \
      const float4 nkx4 = *(const float4*)&sm.vec[cb][sn][3][kg * 4]; \
      const float4 nr4 = *(const float4*)&sm.vec[cb][sn][4][kg * 4]; \
      const float nvv = sm.v[cb][sn][rowb]; \
      const f32x2 d2 = S23 * HI2(kk4) + S01 * LO2(kk4); \
      const f32x2 vv2 = {vv, vv}; \
      const f32x2 t01 = vv2 * LO2(kx4) + S01 * LO2(w4); \
      const f32x2 t23 = vv2 * HI2(kx4) + S23 * HI2(w4); \
      const float d = row16_sum(d2.x + d2.y); \
      const f32x2 dd = {d, d}; \
      S01 = t01 - dd * LO2(b4); \
      S23 = t23 - dd * HI2(b4); \
      const f32x2 y2 = S23 * HI2(r4) + S01 * LO2(r4); \
      sm.yp[s][rowb][kg] = y2.x + y2.y; \
      w4 = nw4; kk4 = nkk4; b4 = nb4; kx4 = nkx4; r4 = nr4; vv = nvv; \
    } \
    {     \
      const float4 p0 = *(const float4*)&sm.yp[ys][yr][0], p1 = *(const float4*)&sm.yp[ys][yr][4]; \
      const float4 p2 = *(const float4*)&sm.yp[ys][yr][8], p3 = *(const float4*)&sm.yp[ys][yr][12]; \
      const float y = ((p0.x + p0.y) + (p0.z + p0.w)) + ((p1.x + p1.y) + (p1.z + p1.w)) + ((p2.x + p2.y) + (p2.z + p2.w)) + ((p3.x + p3.y) + (p3.z + p3.w)); \
      Y[((size_t)b * SEQ + (tc_) + ys) * LDY + hh * 64 + vg * 16 + yr] = f2bf(y); \
    } \
    __syncthreads(); } while (0)
#pragma unroll 1
  for (int tc = 0; tc < SEQ; tc += 32) {
    SCAN_CHUNK(tc, gA, gB, 0);
    SCAN_CHUNK(tc + 16, gB, gA, 1);
  }
  __syncthreads();
}

DI void attn_item(const Params& p, int bh, int qb, SmemAttn& sm) {
  const int tid = threadIdx.x, lane = tid & 63, w = tid >> 6, r = lane & 31, h = lane >> 5;
  char* ws = p.ws;
  const u16* Qb = (const u16*)(ws + O_Q) + (size_t)bh * SEQ * 96;
  const u16* Kb = (const u16*)(ws + O_K) + (size_t)bh * SEQ * 96;
  const u16* Vt = (const u16*)((char*)p.out + D_VT) + (size_t)bh * 64 * LDV;
  const u16* SZB = (const u16*)(ws + O_SZB);
  u16* O = (u16*)((char*)p.out + D_O);
  const int b = bh >> 3, hh = bh & 7;
  const int q0 = qb * 128;
  const int qw = q0 + w * 32;
  const int qg = qw + r;
#if NAIVE_ATTN
  if (h == 0) {
    float m = -1e30f, l = 0.f;
    const size_t t = (size_t)b * SEQ + qg;
    for (int dc = 0; dc < 64; dc += 16) {
      float o[16];
      m = -1e30f; l = 0.f;
#pragma unroll
      for (int d = 0; d < 16; d++) o[d] = 0.f;
      for (int key = 0; key <= qg; key++) {
        float s = 0.f;
        for (int d = 0; d < 96; d++) s += bf2f(Qb[(size_t)qg * 96 + d]) * bf2f(Kb[(size_t)key * 96 + d]);
        float mn = fmaxf(m, s);
        float al = exp2f(m - mn), pp = exp2f(s - mn);
        l = l * al + pp;
#pragma unroll
        for (int d = 0; d < 16; d++) o[d] = o[d] * al + pp * bf2f(Vt[(size_t)(dc + d) * LDV + key]);
        m = mn;
      }
#pragma unroll
      for (int d = 0; d < 16; d++) O[t * LDY + hh * 64 + dc + d] = f2bf(o[d] / l * bf2f(SZB[t * 512 + hh * 64 + dc + d]));
    }
  }
#else
  bf16x8 bq[6];
#pragma unroll
  for (int s = 0; s < 6; s++) bq[s] = *(const bf16x8*)(Qb + (size_t)qg * 96 + s * 16 + h * 8);
  const f32x16 zero16 = {0.f, 0.f, 0.f, 0.f, 0.f, 0.f, 0.f, 0.f, 0.f, 0.f, 0.f, 0.f, 0.f, 0.f, 0.f, 0.f};
  f32x16 oacc[2];
#pragma unroll
  for (int g = 0; g < 16; g++) { oacc[0][g] = 0.f; oacc[1][g] = 0.f; }
  float m_run = -1e30f, l_run = 0.f;
  const int nkt = (q0 + 128) >> 6;
  u32x4 RK0, RK1, RK2, RV0, RV1;
  const int kr0 = tid / 12, kc0 = tid - kr0 * 12;
  const int kr1 = (tid + 256) / 12, kc1 = (tid + 256) - kr1 * 12;
  const int kr2 = (tid + 512) / 12, kc2 = (tid + 512) - kr2 * 12;
  const int vr0 = tid >> 3, vc0 = tid & 7;
#define ATT_KISSUE(kt_) do { const int k0_ = (((kt_) < nkt) ? (kt_) : nkt - 1) << 6; \
    RK0 = *(const u32x4*)(Kb + (size_t)(k0_ + kr0) * 96 + kc0 * 8); \
    RK1 = *(const u32x4*)(Kb + (size_t)(k0_ + kr1) * 96 + kc1 * 8); \
    RK2 = *(const u32x4*)(Kb + (size_t)(k0_ + kr2) * 96 + kc2 * 8); } while (0)
#define ATT_VISSUE(kt_) do { const int k0_ = (((kt_) < nkt) ? (kt_) : nkt - 1) << 6; \
    RV0 = *(const u32x4*)(Vt + (size_t)vr0 * LDV + k0_ + vc0 * 8); \
    RV1 = *(const u32x4*)(Vt + (size_t)(vr0 + 32) * LDV + k0_ + vc0 * 8); } while (0)
#define ATT_KSTASH(buf) do { \
    *(u32x4*)&sm.k[buf][kr0][kc0 * 8] = RK0; *(u32x4*)&sm.k[buf][kr1][kc1 * 8] = RK1; *(u32x4*)&sm.k[buf][kr2][kc2 * 8] = RK2; } while (0)
#define ATT_VSTASH(buf) do { \
    *(u32x4*)&sm.vt[buf][vr0][vc0 * 8] = RV0; *(u32x4*)&sm.vt[buf][vr0 + 32][vc0 * 8] = RV1; } while (0)
#define ATT_S(SD, buf) do { \
      _Pragma("unroll") for (int kb = 0; kb < 2; kb++) { \
        { const bf16x8 kf0 = *(const bf16x8*)&sm.k[buf][kb * 32 + r][h * 8]; \
          SD[kb] = __builtin_amdgcn_mfma_f32_32x32x16_bf16(kf0, bq[0], zero16, 0, 0, 0); } \
        _Pragma("unroll") for (int s = 1; s < 6; s++) { \
          const bf16x8 kf = *(const bf16x8*)&sm.k[buf][kb * 32 + r][s * 16 + h * 8]; \
          SD[kb] = __builtin_amdgcn_mfma_f32_32x32x16_bf16(kf, bq[s], SD[kb], 0, 0, 0); \
        } \
      } } while (0)
#define ATT_SMPV(sacc, kt, buf) do { \
      const int k0 = (kt) << 6; \
      if (k0 + 63 > qw) { \
        _Pragma("unroll") for (int kb = 0; kb < 2; kb++) \
          _Pragma("unroll") for (int g = 0; g < 16; g++) { \
            const int key = k0 + kb * 32 + (g & 3) + 8 * (g >> 2) + 4 * h; \
            if (key > qg) sacc[kb][g] = -1e30f; \
          } \
      } \
      float mloc = -1e30f; \
      _Pragma("unroll") for (int kb = 0; kb < 2; kb++) \
        _Pragma("unroll") for (int g = 0; g < 16; g++) mloc = fmaxf(mloc, sacc[kb][g]); \
      mloc = fmaxf(mloc, __shfl_xor(mloc, 32, 64)); \
      const float m_new = fmaxf(m_run, mloc); \
      if (__any(m_new > m_run)) { \
        const float alpha = __builtin_amdgcn_exp2f(m_run - m_new); \
        l_run *= alpha; \
        _Pragma("unroll") for (int g = 0; g < 16; g++) { oacc[0][g] *= alpha; oacc[1][g] *= alpha; } \
        m_run = m_new; \
      } \
      float psum = 0.f; \
      _Pragma("unroll") for (int kb = 0; kb < 2; kb++) \
        _Pragma("unroll") for (int g = 0; g < 16; g++) { \
          const float pv = __builtin_amdgcn_exp2f(sacc[kb][g] - m_run); \
          sacc[kb][g] = pv; \
          psum += pv; \
        } \
      l_run += psum; \
      _Pragma("unroll") for (int kb = 0; kb < 2; kb++) \
        _Pragma("unroll") for (int sp = 0; sp < 2; sp++) { \
          uint4 pk; \
          pk.x = pack2(sacc[kb][8 * sp + 0], sacc[kb][8 * sp + 1]); \
          pk.y = pack2(sacc[kb][8 * sp + 2], sacc[kb][8 * sp + 3]); \
          pk.z = pack2(sacc[kb][8 * sp + 4], sacc[kb][8 * sp + 5]); \
          pk.w = pack2(sacc[kb][8 * sp + 6], sacc[kb][8 * sp + 7]); \
          const bf16x8 pf = __builtin_bit_cast(bf16x8, pk); \
          _Pragma("unroll") for (int db = 0; db < 2; db++) { \
            const s16x4 lo = *(const s16x4*)&sm.vt[buf][db * 32 + r][kb * 32 + 16 * sp + 4 * h]; \
            const s16x4 hi = *(const s16x4*)&sm.vt[buf][db * 32 + r][kb * 32 + 16 * sp + 8 + 4 * h]; \
            const bf16x8 vf = __builtin_shufflevector(lo, hi, 0, 1, 2, 3, 4, 5, 6, 7); \
            oacc[db] = __builtin_amdgcn_mfma_f32_32x32x16_bf16(vf, pf, oacc[db], 0, 0, 0); \
          } \
        } \
    } while (0)
#define ATT_ITER(kt, SC, SN, par) do { \
    ATT_KSTASH((par) ^ 1); \
    ATT_VSTASH(par); \
    __syncthreads(); \
    ATT_KISSUE((kt) + 2); \
    ATT_VISSUE((kt) + 1); \
    if ((kt) + 1 < nkt && (((kt) + 1) << 6) <= qw + 31) ATT_S(SN, (par) ^ 1); \
    if (((kt) << 6) <= qw + 31) ATT_SMPV(SC, kt, par); \
  } while (0)
  f32x16 SA[2], SB[2];
  ATT_KISSUE(0);
  __syncthreads();
  ATT_KSTASH(0);
  __syncthreads();
  ATT_KISSUE(1);
  ATT_VISSUE(0);
  ATT_S(SA, 0);
#pragma unroll 1
  for (int kt = 0; kt < nkt; kt += 2) {
    ATT_ITER(kt, SA, SB, 0);
    ATT_ITER(kt + 1, SB, SA, 1);
  }
  const float l_tot = l_run + __shfl_xor(l_run, 32, 64);
  const float inv_l = 1.f / l_tot;
  const size_t t = (size_t)b * SEQ + qg;
#pragma unroll
  for (int db = 0; db < 2; db++)
#pragma unroll
    for (int gq = 0; gq < 4; gq++) {
      const int d = db * 32 + 8 * gq + 4 * h;
      const uint2 z = *(const uint2*)(SZB + t * 512 + hh * 64 + d);
      const float z0 = __uint_as_float(z.x << 16), z1 = __uint_as_float(z.x & 0xffff0000u);
      const float z2 = __uint_as_float(z.y << 16), z3 = __uint_as_float(z.y & 0xffff0000u);
      uint2 o;
      o.x = pack2(oacc[db][4 * gq + 0] * inv_l * z0, oacc[db][4 * gq + 1] * inv_l * z1);
      o.y = pack2(oacc[db][4 * gq + 2] * inv_l * z2, oacc[db][4 * gq + 3] * inv_l * z3);
      *(uint2*)(O + t * LDY + hh * 64 + d) = o;
    }
#endif
}

DI void phase4(const Params& p, Smem& sm, int* cnt, int mode = 0) {
  __shared__ int s_v;
  const unsigned xcc = xcc_id();
  if (threadIdx.x == 0) s_v = atomicExch(&cnt[64 + xcc * 256 + cu_key()], 1);
  __syncthreads();
  const bool scan_first = (s_v == 0);
  __syncthreads();
  if (scan_first && mode != 2) {
    if (threadIdx.x == 0) s_v = atomicAdd(&cnt[8], 1);
    __syncthreads();
    const int item = s_v;
    __syncthreads();
    if (item < 256) {
      __builtin_amdgcn_s_setprio(3);
      scan_item(p, item, sm.sc);
      __builtin_amdgcn_s_setprio(0);
    }
  }
  QState qs; qs.q = (int)xcc; qs.tried = 0;
  if (mode != 1) for (;;) {
    const int li = fetch_item(cnt, 256, qs);
    if (li < 0) break;
    attn_item(p, qs.q * 8 + (li >> 5), 31 - (li & 31), sm.at);
  }
  if (mode != 2) for (;;) {
    __syncthreads();
    if (threadIdx.x == 0) s_v = atomicAdd(&cnt[8], 1);
    __syncthreads();
    const int item = s_v;
    if (item >= 256) break;
    scan_item(p, item, sm.sc);
  }
}

DI void phase5(const Params& p) {
  const long gtid = (long)blockIdx.x * 256 + threadIdx.x, nth = (long)gridDim.x * 256;
  const int lane = threadIdx.x & 63, sub = lane >> 4, l16 = lane & 15;
  const long wave = gtid >> 6, nw = nth >> 6;
  char* ws = p.ws;
  const u16* FA = (const u16*)(ws + O_FA);
  const u16* SZA = (const u16*)(ws + O_SZA);
  const float* BONUS = (const float*)(ws + O_BONUS);
  u16* Y = (u16*)((char*)p.out + D_YA);
  for (long it = wave; it < (long)T * 2; it += nw) {
    const long item = it * 4 + sub;
    const long t = item >> 3;
    const int hh = (int)(item & 7), c = hh * 64 + l16 * 4;
    const int s = (int)(t & (SEQ - 1));
    const float4 y = ld4(Y + t * LDY + c);
    const float mean = row16_sum((y.x + y.y) + (y.z + y.w)) * (1.f / 64.f);
    const float d0 = y.x - mean, d1 = y.y - mean, d2 = y.z - mean, d3 = y.w - mean;
    const float var = row16_sum((d0 * d0 + d1 * d1) + (d2 * d2 + d3 * d3)) * (1.f / 64.f);
    const float rstd = rsqrtf(var + GN_EPS);
    const float4 gg = *(const float4*)(p.gn_g + c), gb = *(const float4*)(p.gn_b + c), mu = *(const float4*)(p.mu + 1024 + c);
    const float4 vf = ld4(FA + t * FAW + 1024 + c);
    float4 vp = ld4(FA + (s > 0 ? t - 1 : t) * FAW + 1024 + c);
    if (s == 0) vp = make_float4(0.f, 0.f, 0.f, 0.f);
    const float bon = BONUS[t * 8 + hh];
    const float4 z = ld4(SZA + t * 512 + c);
    float4 o;
    o.x = (d0 * rstd * gg.x + gb.x + bon * (vf.x + mu.x * (vp.x - vf.x))) * z.x;
    o.y = (d1 * rstd * gg.y + gb.y + bon * (vf.y + mu.y * (vp.y - vf.y))) * z.y;
    o.z = (d2 * rstd * gg.z + gb.z + bon * (vf.z + mu.z * (vp.z - vf.z))) * z.z;
    o.w = (d3 * rstd * gg.w + gb.w + bon * (vf.w + mu.w * (vp.w - vf.w))) * z.w;
    st4(Y + t * LDY + c, o);
  }
}

DI void phase6(const Params& p, Smem& sm, int* cnt) {
  char* ws = p.ws;
  const u16* YA = (const u16*)((char*)p.out + D_YA);
  const u16* O = (const u16*)((char*)p.out + D_O);
  const u16* G = (const u16*)(ws + O_G);
  u16* MG = (u16*)(ws + O_U);
  const int xcd = blockIdx.x & 7, lb = blockIdx.x >> 3, nlb = gridDim.x >> 3;
  for (int li = lb; li < 256; li += nlb) {
    const int mt = xcd * 32 + (li >> 3), nt = li & 7;
    f32x16 acc[2][2];
    acc_zero(acc);
    u32 pk1[2][2][8];
    gemm_tile_dual(YA, (const u16*)(ws + O_WOA), O, (const u16*)(ws + O_WOB), LDY, LDY, mt * 128, nt * 128, acc, pk1, sm.g);
    acc_epilogue2(pk1, acc, mt * 128, nt * 128, sm.g,
      [&](int row, int col) {
        const uint2 a = *(const uint2*)(G + (size_t)row * LDG + col), bq = *(const uint2*)(G + (size_t)row * LDG + 1024 + col);
        return make_uint4(a.x, a.y, bq.x, bq.y);
      },
      [&](int row, int col, float4 va, float4 vb, uint4 gp) {
        const float4 ga = make_float4(__uint_as_float(gp.x << 16), __uint_as_float(gp.x & 0xffff0000u), __uint_as_float(gp.y << 16), __uint_as_float(gp.y & 0xffff0000u));
        const float4 gb = make_float4(__uint_as_float(gp.z << 16), __uint_as_float(gp.z & 0xffff0000u), __uint_as_float(gp.w << 16), __uint_as_float(gp.w & 0xffff0000u));
        st4(MG + (size_t)row * LDU + col, make_float4(va.x * ga.x + vb.x * gb.x, va.y * ga.y + vb.y * gb.y,
                                                     va.z * ga.z + vb.z * gb.z, va.w * ga.w + vb.w * gb.w));
      });
  }
}

DI void phase7(const Params& p, Smem& sm, int* cnt) {
  char* ws = p.ws;
  const u16* MG = (const u16*)(ws + O_U);
  u16* TP = (u16*)(ws + O_FA);
  const int xcd = blockIdx.x & 7, lb = blockIdx.x >> 3, nlb = gridDim.x >> 3;
  for (int li = lb; li < 256; li += nlb) {
    const int mt = xcd * 32 + (li >> 3), nt = li & 7;
    f32x16 acc[2][2];
    acc_zero(acc);
    gemm_tile_acc(MG, LDU, (const u16*)(ws + O_WO), LDU, 1024, mt * 128, nt * 128, acc, sm.g);
    acc_epilogue(acc, mt * 128, nt * 128, sm.g, [&](int row, int col, float4 v) { st4(TP + (size_t)row * LDU + col, v); });
  }
}

DI void phase8(const Params& p) {
  int bz;
  asm volatile("v_mov_b32 %0, 0" : "=v"(bz));
  const long gtid = (long)(blockIdx.x + bz) * 256 + threadIdx.x, nth = (long)gridDim.x * 256;
  const int lane = threadIdx.x & 63;
  const long wave = gtid >> 6, nw = nth >> 6;
  const u16* TP = (const u16*)(p.ws + O_FA);
  for (long row = wave; row < T; row += nw) {
    float v[16];
    float ss = 0.f;
#pragma unroll
    for (int i = 0; i < 2; i++) {
      const uint4 u = *(const uint4*)(TP + row * LDU + i * 512 + lane * 8);
      v[i * 8 + 0] = __uint_as_float(u.x << 16); v[i * 8 + 1] = __uint_as_float(u.x & 0xffff0000u);
      v[i * 8 + 2] = __uint_as_float(u.y << 16); v[i * 8 + 3] = __uint_as_float(u.y & 0xffff0000u);
      v[i * 8 + 4] = __uint_as_float(u.z << 16); v[i * 8 + 5] = __uint_as_float(u.z & 0xffff0000u);
      v[i * 8 + 6] = __uint_as_float(u.w << 16); v[i * 8 + 7] = __uint_as_float(u.w & 0xffff0000u);
    }
#pragma unroll
    for (int i = 0; i < 16; i++) ss += v[i] * v[i];
    ss = wave_sum(ss);
    const float rs = rsqrtf(ss * (1.f / 1024.f) + NORM_EPS);
#pragma unroll
    for (int i = 0; i < 4; i++) {
      const int c = (i >> 1) * 512 + lane * 8 + (i & 1) * 4;
      const float4 g = *(const float4*)(p.g_post + c);
      const float4 xx = *(const float4*)(p.x + row * 1024 + c);
      float4 o;
      o.x = xx.x + v[i * 4 + 0] * rs * g.x; o.y = xx.y + v[i * 4 + 1] * rs * g.y;
      o.z = xx.z + v[i * 4 + 2] * rs * g.z; o.w = xx.w + v[i * 4 + 3] * rs * g.w;
      *(float4*)(p.out + row * 1024 + c) = o;
    }
  }
}

__global__ void __launch_bounds__(256, 2) fwd_megakernel(Params p) {
  cg::grid_group grid = cg::this_grid();
  __shared__ Smem sm;
  int* cnt = (int*)(p.ws + O_CNT);
  GBar gb;
  gbar_init(gb, (unsigned*)(p.ws + O_CNT) + 12288);
  if (p.never) grid.sync();
#define GSYNC() gbar_sync(gb)
  phase0(p);
  GSYNC();
  if (PROBE == 0) { phase0(p); GSYNC(); }
  phase1(p, sm, cnt);
  GSYNC();
  if (PROBE == 1) { phase1(p, sm, cnt + 4096); GSYNC(); }
  phase2(p);
  GSYNC();
  if (PROBE == 2) { phase2(p); GSYNC(); }
  phase3(p, sm, cnt + 8);
  GSYNC();
  if (PROBE == 3) { phase3(p, sm, cnt + 4096); GSYNC(); }
  if (PROBE == 41) { phase4(p, sm, cnt + 4096, 1); GSYNC(); }
  if (PROBE == 42) { phase4(p, sm, cnt + 4096, 2); GSYNC(); }
  phase4(p, sm, cnt + 1024);
  GSYNC();
  if (PROBE == 4) { phase4(p, sm, cnt + 4096); GSYNC(); }
  phase5(p);
  GSYNC();
  phase6(p, sm, cnt + 16);
  GSYNC();
  if (PROBE == 6) { phase6(p, sm, cnt + 4096); GSYNC(); }
  phase7(p, sm, cnt + 24);
  GSYNC();
  if (PROBE == 7) { phase7(p, sm, cnt + 4096); GSYNC(); }
  if (PROBE == 80) { for (int rep = 0; rep < 8; rep++) GSYNC(); }
  phase8(p);
}

extern "C" void kernel_launch(void* const* d_in, const int* in_sizes, int n_in,
                              void* d_out, int out_size, void* d_ws, size_t ws_size,
                              hipStream_t stream) {
  static int grid_blocks = 0;
  if (!grid_blocks) {
    int dev = 0, cus = 0, per_cu = 0;
    hipGetDevice(&dev);
    hipDeviceGetAttribute(&cus, hipDeviceAttributeMultiprocessorCount, dev);
    hipOccupancyMaxActiveBlocksPerMultiprocessor(&per_cu, fwd_megakernel, 256, 0);
    if (per_cu > 2) per_cu = 2;
    if (per_cu < 1) per_cu = 1;
    grid_blocks = cus * per_cu;
  }
  if (ws_size < WS_NEED) { fprintf(stderr, "workspace too small: %zu < %zu\n", ws_size, (size_t)WS_NEED); return; }
  Params p{};
  p.x = (const float*)d_in[0]; p.pos = (const int*)d_in[1]; p.g_pre = (const float*)d_in[2]; p.w_in = (const float*)d_in[3];
  p.b_gate = (const float*)d_in[4]; p.mu = (const float*)d_in[5]; p.w0 = (const float*)d_in[6]; p.w_dec = (const float*)d_in[7];
  p.a0 = (const float*)d_in[8]; p.w_icl = (const float*)d_in[9]; p.k_k = (const float*)d_in[10]; p.k_a = (const float*)d_in[11];
  p.r_k = (const float*)d_in[12]; p.gn_g = (const float*)d_in[13]; p.gn_b = (const float*)d_in[14]; p.w_oa = (const float*)d_in[15];
  p.g_q = (const float*)d_in[16]; p.w_uq = (const float*)d_in[17]; p.g_kv = (const float*)d_in[18]; p.w_ukv = (const float*)d_in[19];
  p.w_ob = (const float*)d_in[20]; p.w_o = (const float*)d_in[21]; p.g_post = (const float*)d_in[22];
  p.out = (float*)d_out; p.ws = (char*)d_ws;
  p.never = 0;
  (void)hipMemsetAsync((char*)d_ws + O_CNT, 0, 65536, stream);
  void* args[] = {&p};
  hipError_t e = hipLaunchCooperativeKernel((void*)fwd_megakernel, dim3(grid_blocks), dim3(256), args, 0, stream);
  if (e != hipSuccess) fprintf(stderr, "cooperative launch failed: %s (grid %d)\n", hipGetErrorString(e), grid_blocks);
}
```

```cpp
#include <hip/hip_runtime.h>
#include <hip/hip_cooperative_groups.h>
#include <cstdio>
namespace cg = cooperative_groups;

#ifndef PROBE
#define PROBE -1
#endif
#ifndef NAIVE_GEMM
#define NAIVE_GEMM 0
#endif
#ifndef NAIVE_ATTN
#define NAIVE_ATTN 0
#endif

typedef unsigned short u16;
typedef unsigned int u32;
typedef __attribute__((ext_vector_type(8))) short bf16x8;
typedef __attribute__((ext_vector_type(4))) short s16x4;
typedef __attribute__((ext_vector_type(16))) float f32x16;
#define DI __device__ __forceinline__

constexpr int T = 32768, SEQ = 4096, NB = 8, DM = 1024;
constexpr int INC = 5152, INP = 5248;
constexpr int FAW = 1664;
constexpr int C_ZA = 1664, C_CQ = 2176, C_ZB = 2592, C_G = 3104;
constexpr int LDU = 1088, LDY = 576, LDG = 2112, LDV = 4160, LDQW = 320;
constexpr int CQW = 416;
constexpr float DECAY_SCALE = 0.6065306597f;
constexpr float GN_EPS = 64e-5f;
constexpr float NORM_EPS = 1e-6f;

constexpr size_t O_WIN = 0;
constexpr size_t O_WUQ = O_WIN + (size_t)INP * LDU * 2;
constexpr size_t O_WUKV = O_WUQ + 768 * LDQW * 2;
constexpr size_t O_WOA = O_WUKV + 1024 * 128 * 2;
constexpr size_t O_WOB = O_WOA + 1024 * LDY * 2;
constexpr size_t O_WO = O_WOB + 1024 * LDY * 2;
constexpr size_t O_WDEC = O_WO + 1024 * LDU * 2;
constexpr size_t O_WICL = O_WDEC + 512 * 64 * 2;
constexpr size_t O_RSQ = O_WICL + 512 * 64 * 2;
constexpr size_t O_RSKV = O_RSQ + (size_t)T * 4;
constexpr size_t O_BONUS = O_RSKV + (size_t)T * 4;
constexpr size_t O_CS = O_BONUS + (size_t)T * 8 * 4;
constexpr size_t O_CNT = O_CS + (size_t)T * 32 * 4;
constexpr size_t O_U = O_CNT + 65536;
constexpr size_t O_FA = O_U + (size_t)T * LDU * 2;
constexpr size_t O_SZA = O_FA + (size_t)T * FAW * 2;
constexpr size_t O_SZB = O_SZA + (size_t)T * 512 * 2;
constexpr size_t O_CQKV = O_SZB + (size_t)T * 512 * 2;
constexpr size_t O_G = O_CQKV + (size_t)T * CQW * 2;
constexpr size_t O_Q = O_G + (size_t)T * LDG * 2;
constexpr size_t O_K = O_Q + (size_t)T * 768 * 2;
constexpr size_t WS_NEED = O_K + (size_t)T * 768 * 2;
static_assert(WS_NEED <= (size_t)536870912, "workspace budget");
constexpr size_t D_YA = 0;
constexpr size_t D_O = D_YA + (size_t)T * LDY * 2;
constexpr size_t D_VT = D_O + (size_t)T * LDY * 2;
constexpr size_t D_LA = D_VT + (size_t)64 * 64 * LDV * 2;
static_assert(D_LA + (size_t)T * 128 * 2 <= (size_t)T * 1024 * 4, "d_out scratch budget");

struct Params {
  const float* x; const int* pos; const float* g_pre; const float* w_in; const float* b_gate; const float* mu;
  const float* w0; const float* w_dec; const float* a0; const float* w_icl; const float* k_k; const float* k_a;
  const float* r_k; const float* gn_g; const float* gn_b; const float* w_oa; const float* g_q; const float* w_uq;
  const float* g_kv; const float* w_ukv; const float* w_ob; const float* w_o; const float* g_post;
  float* out; char* ws; long never;
};

DI u16 f2bf(float x) { u32 u = __float_as_uint(x); u += 0x7fffu + ((u >> 16) & 1u); return (u16)(u >> 16); }
DI float bf2f(u16 b) { return __uint_as_float(((u32)b) << 16); }
typedef __attribute__((ext_vector_type(2))) float f32x2;
typedef __attribute__((ext_vector_type(2))) __bf16 bf16x2_t;
DI u32 pack2(float a, float b) { f32x2 v = {a, b}; bf16x2_t q = __builtin_convertvector(v, bf16x2_t); return __builtin_bit_cast(u32, q); }
DI void st4(u16* p, float4 v) { uint2 o; o.x = pack2(v.x, v.y); o.y = pack2(v.z, v.w); *(uint2*)p = o; }
DI float4 ld4(const u16* p) { const uint2 u = *(const uint2*)p; return make_float4(__uint_as_float(u.x << 16), __uint_as_float(u.x & 0xffff0000u), __uint_as_float(u.y << 16), __uint_as_float(u.y & 0xffff0000u)); }
DI float sigmoidf_(float x) { return __builtin_amdgcn_rcpf(1.f + __expf(-x)); }
DI float siluf_(float x) { return x * __builtin_amdgcn_rcpf(1.f + __expf(-x)); }
DI float wave_sum(float v) {
#pragma unroll
  for (int o = 32; o > 0; o >>= 1) v += __shfl_xor(v, o, 64);
  return v;
}
template <int CTRL> DI float dpp_mov(float x) {
  return __builtin_bit_cast(float, __builtin_amdgcn_update_dpp(0, __builtin_bit_cast(int, x), CTRL, 0xf, 0xf, true));
}
DI float row16_sum(float x) {
  x += dpp_mov<0xB1>(x);
  x += dpp_mov<0x4E>(x);
  x += dpp_mov<0x141>(x);
  x += dpp_mov<0x140>(x);
  return x;
}


DI unsigned xcc_id() { return (unsigned)__builtin_amdgcn_s_getreg((3 << 11) | 20) & 0x7u; }
DI unsigned cu_key() { return ((unsigned)__builtin_amdgcn_s_getreg(63492) >> 8) & 0xffu; }
struct QState { int q, tried; };
DI int fetch_item(int* cnt, int per_q, QState& st) {
  __shared__ int s_q, s_tr, s_it;
  __syncthreads();
  if (threadIdx.x == 0) {
    int qq = st.q, tr = st.tried, it = -1;
    while (tr < 8) {
      it = atomicAdd(&cnt[qq], 1);
      if (it < per_q) break;
      it = -1; qq = (qq + 1) & 7; tr++;
    }
    s_q = qq; s_tr = tr; s_it = it;
  }
  __syncthreads();
  st.q = s_q; st.tried = s_tr;
  return s_it;
}


#define XB_XCNT(j) (64 * (j))
#define XB_XSUB(j) (512 + 64 * (j))
#define XB_XGEN(j) (1024 + 64 * (j))
#define XB_TOP 1536
#define XB_TOPGEN 1600
DI unsigned xb_ld(unsigned* p) { return __hip_atomic_load(p, __ATOMIC_RELAXED, __HIP_MEMORY_SCOPE_AGENT); }
DI unsigned xb_add(unsigned* p, unsigned v) { return __hip_atomic_fetch_add(p, v, __ATOMIC_RELAXED, __HIP_MEMORY_SCOPE_AGENT); }
struct GBar { unsigned* bar; unsigned x, nloc, nx; };
DI void gbar_init(GBar& g, unsigned* bar) {
  g.bar = bar; g.x = xcc_id(); g.nloc = 0; g.nx = 0;
  if (threadIdx.x == 0) (void)xb_add(&bar[XB_XCNT(g.x)], 1u);
}
DI void gbar_sync(GBar& g) {
  asm volatile("s_waitcnt vmcnt(0)" ::: "memory");
  __syncthreads();
  if (threadIdx.x == 0) {
    unsigned* bar = g.bar;
    if (g.nloc == 0u) {
      unsigned sum, cnt, mine;
      for (;;) {
        sum = 0u; cnt = 0u; mine = 0u;
#pragma unroll
        for (unsigned j = 0; j < 8; ++j) { const unsigned c = xb_ld(&bar[XB_XCNT(j)]); sum += c; cnt += (c > 0u) ? 1u : 0u; mine = (j == g.x) ? c : mine; }
        if (sum == gridDim.x) break;
        __builtin_amdgcn_s_sleep(1);
      }
      g.nloc = mine; g.nx = cnt;
    }
    const unsigned old = xb_add(&bar[XB_XSUB(g.x)], 1u);
    const unsigned gen = old / g.nloc;
    if (old + 1u == (gen + 1u) * g.nloc) {
      __builtin_amdgcn_fence(__ATOMIC_RELEASE, "agent");
      asm volatile("s_waitcnt vmcnt(0)" ::: "memory");
      const unsigned og = xb_add(&bar[XB_TOP], 1u);
      const unsigned tg = og / g.nx;
      if (og + 1u == (tg + 1u) * g.nx) xb_add(&bar[XB_TOPGEN], 1u);
      else while (xb_ld(&bar[XB_TOPGEN]) == tg) __builtin_amdgcn_s_sleep(1);
      __builtin_amdgcn_fence(__ATOMIC_ACQUIRE, "agent");
      xb_add(&bar[XB_XGEN(g.x)], 1u);
      asm volatile("s_waitcnt vmcnt(0)" ::: "memory");
    } else {
      while (xb_ld(&bar[XB_XGEN(g.x)]) == gen) __builtin_amdgcn_s_sleep(1);
      __builtin_amdgcn_fence(__ATOMIC_ACQUIRE, "agent");
      asm volatile("s_waitcnt vmcnt(0)" ::: "memory");
    }
  }
  __syncthreads();
}

struct SmemGemm { u16 a[2][128][72]; u16 b[2][128][72]; };
struct SmemAttn { u16 k[2][64][104]; u16 vt[2][64][72]; };
struct SmemScan { float vec[2][16][5][64]; float v[2][16][16]; float yp[16][16][16]; };
union __attribute__((aligned(16))) Smem { SmemGemm g; SmemAttn at; SmemScan sc; };

typedef __attribute__((ext_vector_type(4))) unsigned int u32x4;
#define G_LOAD(R, k0) do { \
    R##a0 = *(const u32x4*)(Ap + (k0)); R##a1 = *(const u32x4*)(Ap + sa32 + (k0)); R##a2 = *(const u32x4*)(Ap + 2 * sa32 + (k0)); R##a3 = *(const u32x4*)(Ap + 3 * sa32 + (k0)); \
    R##b0 = *(const u32x4*)(Bp + (k0)); R##b1 = *(const u32x4*)(Bp + sb32 + (k0)); R##b2 = *(const u32x4*)(Bp + 2 * sb32 + (k0)); R##b3 = *(const u32x4*)(Bp + 3 * sb32 + (k0)); } while (0)
#define G_STORE(buf, R) do { \
    *(u32x4*)&sm.a[buf][lrow][lkc] = R##a0; *(u32x4*)&sm.a[buf][lrow + 32][lkc] = R##a1; *(u32x4*)&sm.a[buf][lrow + 64][lkc] = R##a2; *(u32x4*)&sm.a[buf][lrow + 96][lkc] = R##a3; \
    *(u32x4*)&sm.b[buf][lrow][lkc] = R##b0; *(u32x4*)&sm.b[buf][lrow + 32][lkc] = R##b1; *(u32x4*)&sm.b[buf][lrow + 64][lkc] = R##b2; *(u32x4*)&sm.b[buf][lrow + 96][lkc] = R##b3; } while (0)
#define G_COMPUTE_LOW(buf) do {     \
    _Pragma("unroll") for (int s = 0; s < 4; s++) { \
      bf16x8 af[2], bfr[2]; \
      _Pragma("unroll") for (int i = 0; i < 2; i++) af[i] = *(const bf16x8*)&sm.a[buf][wm * 64 + i * 32 + r][s * 16 + h * 8]; \
      _Pragma("unroll") for (int j = 0; j < 2; j++) bfr[j] = *(const bf16x8*)&sm.b[buf][wn * 64 + j * 32 + r][s * 16 + h * 8]; \
      _Pragma("unroll") for (int i = 0; i < 2; i++) \
        _Pragma("unroll") for (int j = 0; j < 2; j++) acc[i][j] = __builtin_amdgcn_mfma_f32_32x32x16_bf16(af[i], bfr[j], acc[i][j], 0, 0, 0); \
    } } while (0)
#define G_COMPUTE(buf) do { \
    if (VAR == 1) { G_COMPUTE_LOW(buf); break; } \
    _Pragma("unroll") for (int hs = 0; hs < 2; hs++) {     \
      bf16x8 af[2][2], bfr[2][2]; \
      _Pragma("unroll") for (int s = 0; s < 2; s++) { \
        _Pragma("unroll") for (int i = 0; i < 2; i++) af[s][i] = *(const bf16x8*)&sm.a[buf][wm * 64 + i * 32 + r][(hs * 2 + s) * 16 + h * 8]; \
        _Pragma("unroll") for (int j = 0; j < 2; j++) bfr[s][j] = *(const bf16x8*)&sm.b[buf][wn * 64 + j * 32 + r][(hs * 2 + s) * 16 + h * 8]; \
      } \
      __builtin_amdgcn_sched_barrier(0); \
      _Pragma("unroll") for (int s = 0; s < 2; s++) \
        _Pragma("unroll") for (int i = 0; i < 2; i++) \
          _Pragma("unroll") for (int j = 0; j < 2; j++) acc[i][j] = __builtin_amdgcn_mfma_f32_32x32x16_bf16(af[s][i], bfr[s][j], acc[i][j], 0, 0, 0); \
      __builtin_amdgcn_sched_barrier(0); \
    } \
  } while (0)
#define G_STEP(kt, bufc, bufn) do { \
    const int kl_ = ((kt) + 2 < nk) ? (kt) + 2 : nk - 1;     \
    G_COMPUTE(bufc); \
    G_STORE(bufn, R0); \
    G_LOAD(R0, kl_ << 6); \
    __syncthreads(); } while (0)

template <int VAR = 0> DI void gemm_tile_acc(const u16* __restrict__ A, int lda, const u16* __restrict__ Bt, int ldb, int K,
                      int m0, int n0, f32x16 (&acc)[2][2], SmemGemm& sm) {
  const int tid = threadIdx.x, lane = tid & 63, w = tid >> 6, wm = w >> 1, wn = w & 1, r = lane & 31, h = lane >> 5;
  const int lrow = tid >> 3, lkc = (tid & 7) * 8;
  const u16* Ap = A + (size_t)(m0 + lrow) * lda + lkc;
  const u16* Bp = Bt + (size_t)(n0 + lrow) * ldb + lkc;
  const size_t sa32 = (size_t)32 * lda, sb32 = (size_t)32 * ldb;
  const int nk = K >> 6;
  u32x4 R0a0, R0a1, R0a2, R0a3, R0b0, R0b1, R0b2, R0b3;
  G_LOAD(R0, 0);
  __syncthreads();
  G_STORE(0, R0);
  if (nk == 1) {
    __syncthreads();
    G_COMPUTE(0);
    __syncthreads();
    return;
  }
  G_LOAD(R0, 64);
  __syncthreads();
  __builtin_amdgcn_s_setprio(1);
#pragma unroll 1
  for (int kt = 0; kt < nk; kt += 2) {
    G_STEP(kt, 0, 1);
    G_STEP(kt + 1, 1, 0);
  }
  __builtin_amdgcn_s_setprio(0);
}

DI void gemm_tile_dual(const u16* __restrict__ A1, const u16* __restrict__ B1, const u16* __restrict__ A2, const u16* __restrict__ B2,
                       int lda, int ldb, int m0, int n0, f32x16 (&acc)[2][2], u32 (&pk1)[2][2][8], SmemGemm& sm) {
  constexpr int VAR = 1;
  const int tid = threadIdx.x, lane = tid & 63, w = tid >> 6, wm = w >> 1, wn = w & 1, r = lane & 31, h = lane >> 5;
  const int lrow = tid >> 3, lkc = (tid & 7) * 8;
  const u16* A1p = A1 + (size_t)(m0 + lrow) * lda + lkc;
  const u16* B1p = B1 + (size_t)(n0 + lrow) * ldb + lkc;
  const u16* A2p = A2 + (size_t)(m0 + lrow) * lda + lkc;
  const u16* B2p = B2 + (size_t)(n0 + lrow) * ldb + lkc;
  const size_t sa32 = (size_t)32 * lda, sb32 = (size_t)32 * ldb;
  constexpr int nk = 16;
  u32x4 R0a0, R0a1, R0a2, R0a3, R0b0, R0b1, R0b2, R0b3;
#define GD_LOAD(kl) do { const int kl_ = (kl) < nk ? (kl) : nk - 1; \
    const u16* Ap = (kl_ < 8) ? A1p : A2p; const u16* Bp = (kl_ < 8) ? B1p : B2p; G_LOAD(R0, (kl_ & 7) << 6); } while (0)
#define GD_STEP(kt, bufc, bufn) do { G_COMPUTE(bufc); G_STORE(bufn, R0); GD_LOAD((kt) + 2); __syncthreads(); } while (0)
  GD_LOAD(0);
  __syncthreads();
  G_STORE(0, R0);
  GD_LOAD(1);
  __syncthreads();
  __builtin_amdgcn_s_setprio(1);
#pragma unroll 1
  for (int kt = 0; kt < nk; kt += 2) {
    if (kt == 8) {
#pragma unroll
      for (int i = 0; i < 2; i++)
#pragma unroll
        for (int j = 0; j < 2; j++) {
#pragma unroll
          for (int q = 0; q < 8; q++) pk1[i][j][q] = pack2(acc[i][j][2 * q], acc[i][j][2 * q + 1]);
#pragma unroll
          for (int g = 0; g < 16; g++) acc[i][j][g] = 0.f;
        }
    }
    GD_STEP(kt, 0, 1);
    GD_STEP(kt + 1, 1, 0);
  }
  __builtin_amdgcn_s_setprio(0);
}

DI void acc_zero(f32x16 (&acc)[2][2]) {
#pragma unroll
  for (int i = 0; i < 2; i++)
#pragma unroll
    for (int j = 0; j < 2; j++)
#pragma unroll
      for (int g = 0; g < 16; g++) acc[i][j][g] = 0.f;
}

DI void acc_stage(f32x16 (&acc)[2][2], SmemGemm& sm) {
  const int lane = threadIdx.x & 63, w = threadIdx.x >> 6, r = lane & 31, h = lane >> 5;
  float* wb = (float*)&sm + w * (64 * 68);
#pragma unroll
  for (int i = 0; i < 2; i++)
#pragma unroll
    for (int j = 0; j < 2; j++)
#pragma unroll
      for (int g = 0; g < 16; g++)
        wb[(i * 32 + (g & 3) + 8 * (g >> 2) + 4 * h) * 68 + j * 32 + r] = acc[i][j][g];
  __syncthreads();
}
template <class F> DI void acc_drain(int m0, int n0, SmemGemm& sm, F f) {
  const int lane = threadIdx.x & 63, w = threadIdx.x >> 6, wm = w >> 1, wn = w & 1;
  const float* wb = (const float*)&sm + w * (64 * 68);
  const int rl = lane >> 4, c4 = (lane & 15) * 4;
#pragma unroll 4
  for (int it = 0; it < 16; it++) {
    const int row_l = it * 4 + rl;
    const float4 v = *(const float4*)&wb[row_l * 68 + c4];
    f(m0 + wm * 64 + row_l, n0 + wn * 64 + c4, v);
  }
}
template <class L, class F> DI void acc_drain_grp(int m0, int n0, SmemGemm& sm, L ldg, F f) {
  const int lane = threadIdx.x & 63, w = threadIdx.x >> 6, wm = w >> 1, wn = w & 1;
  const float* wb = (const float*)&sm + w * (64 * 68);
  const int rl = lane >> 4, c4 = (lane & 15) * 4;
#pragma unroll 1
  for (int g4 = 0; g4 < 4; g4++) {
    decltype(ldg(0, 0)) gl[4];
#pragma unroll
    for (int k = 0; k < 4; k++) gl[k] = ldg(m0 + wm * 64 + (g4 * 4 + k) * 4 + rl, n0 + wn * 64 + c4);
#pragma unroll
    for (int k = 0; k < 4; k++) {
      const int row_l = (g4 * 4 + k) * 4 + rl;
      const float4 v = *(const float4*)&wb[row_l * 68 + c4];
      f(m0 + wm * 64 + row_l, n0 + wn * 64 + c4, v, gl[k]);
    }
  }
}
template <class F> DI void acc_epilogue(f32x16 (&acc)[2][2], int m0, int n0, SmemGemm& sm, F f) {
  acc_stage(acc, sm);
  acc_drain(m0, n0, sm, f);
}

template <class L, class F> DI void acc_epilogue2(const u32 (&pk1)[2][2][8], f32x16 (&acc2)[2][2], int m0, int n0, SmemGemm& sm, L ldg, F f) {
  const int lane = threadIdx.x & 63, w = threadIdx.x >> 6, wm = w >> 1, wn = w & 1, r = lane & 31, h = lane >> 5;
  float* wb = (float*)&sm + w * (64 * 68);
  const int rl = lane >> 4, c4 = (lane & 15) * 4;
  int lz;
  asm volatile("v_mov_b32 %0, 0" : "=v"(lz));
  m0 += lz;
  uint2 v1[16];
#pragma unroll
  for (int i = 0; i < 2; i++)
#pragma unroll
    for (int j = 0; j < 2; j++)
#pragma unroll
      for (int q = 0; q < 8; q++) {
        const int g0 = 2 * q, g1 = 2 * q + 1;
        wb[(i * 32 + (g0 & 3) + 8 * (g0 >> 2) + 4 * h) * 68 + j * 32 + r] = __uint_as_float(pk1[i][j][q] << 16);
        wb[(i * 32 + (g1 & 3) + 8 * (g1 >> 2) + 4 * h) * 68 + j * 32 + r] = __uint_as_float(pk1[i][j][q] & 0xffff0000u);
      }
  __syncthreads();
#pragma unroll
  for (int it = 0; it < 16; it++) {
    const float4 t = *(const float4*)&wb[(it * 4 + rl) * 68 + c4];
    v1[it] = make_uint2(pack2(t.x, t.y), pack2(t.z, t.w));
  }
  __syncthreads();
#pragma unroll
  for (int i = 0; i < 2; i++)
#pragma unroll
    for (int j = 0; j < 2; j++)
#pragma unroll
      for (int g = 0; g < 16; g++)
        wb[(i * 32 + (g & 3) + 8 * (g >> 2) + 4 * h) * 68 + j * 32 + r] = acc2[i][j][g];
  __syncthreads();
#pragma unroll
  for (int g4 = 0; g4 < 4; g4++) {
    uint4 gl[4];
#pragma unroll
    for (int k = 0; k < 4; k++) gl[k] = ldg(m0 + wm * 64 + (g4 * 4 + k) * 4 + rl, n0 + wn * 64 + c4);
#pragma unroll
    for (int k = 0; k < 4; k++) {
      const int it = g4 * 4 + k, row_l = it * 4 + rl;
      const float4 v2 = *(const float4*)&wb[row_l * 68 + c4];
      const float4 va = make_float4(__uint_as_float(v1[it].x << 16), __uint_as_float(v1[it].x & 0xffff0000u),
                                    __uint_as_float(v1[it].y << 16), __uint_as_float(v1[it].y & 0xffff0000u));
      f(m0 + wm * 64 + row_l, n0 + wn * 64 + c4, va, v2, gl[k]);
    }
  }
}

DI float4 silu4(float4 v) { return make_float4(siluf_(v.x), siluf_(v.y), siluf_(v.z), siluf_(v.w)); }
DI float4 sigm4(float4 v) { return make_float4(sigmoidf_(v.x), sigmoidf_(v.y), sigmoidf_(v.z), sigmoidf_(v.w)); }

DI void transpose_cvt(const float* __restrict__ src, int K, int N, u16* __restrict__ dst, int ldd, const float* __restrict__ kscale,
                      long gtid, long nth) {
  const long tot = (long)(K >> 3) * N;
  for (long idx = gtid; idx < tot; idx += nth) {
    const int kb = (int)(idx / N), n = (int)(idx - (long)kb * N), k0 = kb * 8;
    float v[8];
#pragma unroll
    for (int j = 0; j < 8; j++) v[j] = src[(size_t)(k0 + j) * N + n];
    if (kscale) {
#pragma unroll
      for (int j = 0; j < 8; j++) v[j] *= kscale[k0 + j];
    }
    uint4 o;
    o.x = pack2(v[0], v[1]); o.y = pack2(v[2], v[3]); o.z = pack2(v[4], v[5]); o.w = pack2(v[6], v[7]);
    *(uint4*)(dst + (size_t)n * ldd + k0) = o;
  }
}

DI void phase0(const Params& p) {
  const long gtid = (long)blockIdx.x * 256 + threadIdx.x, nth = (long)gridDim.x * 256;
  char* ws = p.ws;
  transpose_cvt(p.w_in, 1024, INC, (u16*)(ws + O_WIN), LDU, nullptr, gtid, nth);
  for (long idx = gtid; idx < (long)(INP - INC) * LDU; idx += nth) ((u16*)(ws + O_WIN))[(size_t)INC * LDU + idx] = 0;
  transpose_cvt(p.w_uq, 256, 768, (u16*)(ws + O_WUQ), LDQW, p.g_q, gtid, nth);
  transpose_cvt(p.w_ukv, 128, 1024, (u16*)(ws + O_WUKV), 128, p.g_kv, gtid, nth);
  transpose_cvt(p.w_oa, 512, 1024, (u16*)(ws + O_WOA), LDY, nullptr, gtid, nth);
  transpose_cvt(p.w_ob, 512, 1024, (u16*)(ws + O_WOB), LDY, nullptr, gtid, nth);
  transpose_cvt(p.w_o, 1024, 1024, (u16*)(ws + O_WO), LDU, nullptr, gtid, nth);
  transpose_cvt(p.w_dec, 64, 512, (u16*)(ws + O_WDEC), 64, nullptr, gtid, nth);
  transpose_cvt(p.w_icl, 64, 512, (u16*)(ws + O_WICL), 64, nullptr, gtid, nth);

  const int lane = threadIdx.x & 63;
  const long wave = gtid >> 6, nw = nth >> 6;
  u16* U = (u16*)(ws + O_U);
  for (long row = wave; row < T; row += nw) {
    const float4* xr = (const float4*)(p.x + row * 1024);
    float4 v[4];
    float ss = 0.f;
#pragma unroll
    for (int i = 0; i < 4; i++) { v[i] = xr[lane + 64 * i]; ss += v[i].x * v[i].x + v[i].y * v[i].y + v[i].z * v[i].z + v[i].w * v[i].w; }
    ss = wave_sum(ss);
    const float rs = rsqrtf(ss * (1.f / 1024.f) + NORM_EPS);
#pragma unroll
    for (int i = 0; i < 4; i++) {
      float4 g = ((const float4*)p.g_pre)[lane + 64 * i];
      uint2 o;
      o.x = pack2(v[i].x * rs * g.x, v[i].y * rs * g.y);
      o.y = pack2(v[i].z * rs * g.z, v[i].w * rs * g.w);
      *(uint2*)(U + row * LDU + (lane + 64 * i) * 4) = o;
    }
  }
}

DI void phase1(const Params& p, Smem& sm, int* cnt) {
  char* ws = p.ws;
  const u16* U = (const u16*)(ws + O_U);
  const u16* W = (const u16*)(ws + O_WIN);
  u16* FA = (u16*)(ws + O_FA); u16* SZA = (u16*)(ws + O_SZA); u16* SZB = (u16*)(ws + O_SZB);
  u16* CQKV = (u16*)(ws + O_CQKV); u16* G = (u16*)(ws + O_G);
  const float* bg = p.b_gate;
  const int xcd = blockIdx.x & 7, lb = blockIdx.x >> 3, nlb = gridDim.x >> 3;
  for (int li = lb; li < 32 * 41; li += nlb) {
    const int g = li / 328, rem = li - g * 328, nt = rem >> 3, mt = xcd * 32 + g * 8 + (rem & 7);
    f32x16 acc[2][2];
    acc_zero(acc);
    gemm_tile_acc(U, LDU, W, LDU, 1024, mt * 128, nt * 128, acc, sm.g);
    acc_stage(acc, sm.g);
    const int cw = __builtin_amdgcn_readfirstlane(nt * 128 + ((threadIdx.x >> 6) & 1) * 64);
    const int m0 = mt * 128, n0 = nt * 128;
    if (cw + 64 <= C_ZA) {
      acc_drain(m0, n0, sm.g, [&](int row, int col, float4 v) { st4(FA + (size_t)row * FAW + col, v); });
    } else if (cw >= C_ZA && cw + 64 <= C_CQ) {
      acc_drain(m0, n0, sm.g, [&](int row, int col, float4 v) { st4(SZA + (size_t)row * 512 + (col - C_ZA), silu4(v)); });
    } else if (cw >= C_ZB && cw + 64 <= C_G) {
      acc_drain(m0, n0, sm.g, [&](int row, int col, float4 v) { st4(SZB + (size_t)row * 512 + (col - C_ZB), silu4(v)); });
    } else if (cw >= C_G && cw + 64 <= INC) {
      const float4 bb = *(const float4*)(bg + (n0 + ((threadIdx.x >> 6) & 1) * 64 + (threadIdx.x & 15) * 4 - C_G));
      acc_drain(m0, n0, sm.g, [&](int row, int col, float4 v) {
        st4(G + (size_t)row * LDG + (col - C_G), sigm4(make_float4(v.x + bb.x, v.y + bb.y, v.z + bb.z, v.w + bb.w)));
      });
    } else {
      acc_drain(m0, n0, sm.g, [&](int row, int col, float4 v) {
        if (col < C_ZA) st4(FA + (size_t)row * FAW + col, v);
        else if (col < C_CQ) st4(SZA + (size_t)row * 512 + (col - C_ZA), silu4(v));
        else if (col < C_ZB) st4(CQKV + (size_t)row * CQW + (col - C_CQ), v);
        else if (col < C_G) st4(SZB + (size_t)row * 512 + (col - C_ZB), silu4(v));
        else if (col < INC) {
          const float4 bb = *(const float4*)(bg + (col - C_G));
          st4(G + (size_t)row * LDG + (col - C_G), sigm4(make_float4(v.x + bb.x, v.y + bb.y, v.z + bb.z, v.w + bb.w)));
        }
      });
    }
  }
}

DI void phase2(const Params& p) {
  const long gtid = (long)blockIdx.x * 256 + threadIdx.x, nth = (long)gridDim.x * 256;
  const int lane = threadIdx.x & 63, sub = lane >> 4, l16 = lane & 15;
  const long wave = gtid >> 6, nw = nth >> 6;
  char* ws = p.ws;
  const u16* FA = (const u16*)(ws + O_FA);
  const u16* CQKV = (const u16*)(ws + O_CQKV);
  u16* LA = (u16*)((char*)p.out + D_LA);
  u16* Kb = (u16*)(ws + O_K);
  float* RSQ = (float*)(ws + O_RSQ); float* RSKV = (float*)(ws + O_RSKV);
  float* CS = (float*)(ws + O_CS);
  const float4 mu_wd = *(const float4*)(p.mu + 1536 + l16 * 4), mu_ad = *(const float4*)(p.mu + 1600 + l16 * 4);
  const float inv_freq = powf(10000.0f, -(float)l16 / 16.0f);
  for (long it = wave; it < T / 4; it += nw) {
    const long t = it * 4 + sub;
    const int s = (int)(t & (SEQ - 1)), b = (int)(t >> 12);
    const u16* fa = FA + t * FAW;
    const u16* fp = (s > 0) ? fa - FAW : fa;
    {
      const float4 f = ld4(fa + 1536 + l16 * 4);
      float4 pv = ld4(fp + 1536 + l16 * 4);
      if (s == 0) pv = make_float4(0.f, 0.f, 0.f, 0.f);
      st4(LA + t * 128 + l16 * 4, make_float4(tanhf(f.x + mu_wd.x * (pv.x - f.x)), tanhf(f.y + mu_wd.y * (pv.y - f.y)),
                                              tanhf(f.z + mu_wd.z * (pv.z - f.z)), tanhf(f.w + mu_wd.w * (pv.w - f.w))));
      const float4 f2 = ld4(fa + 1600 + l16 * 4);
      float4 pv2 = ld4(fp + 1600 + l16 * 4);
      if (s == 0) pv2 = make_float4(0.f, 0.f, 0.f, 0.f);
      st4(LA + t * 128 + 64 + l16 * 4, make_float4(f2.x + mu_ad.x * (pv2.x - f2.x), f2.y + mu_ad.y * (pv2.y - f2.y),
                                                   f2.z + mu_ad.z * (pv2.z - f2.z), f2.w + mu_ad.w * (pv2.w - f2.w)));
    }
    const u16* c = CQKV + t * CQW;
    float ss = 0.f, ss2 = 0.f;
#pragma unroll
    for (int i = 0; i < 4; i++) { const float4 v = ld4(c + i * 64 + l16 * 4); ss += (v.x * v.x + v.y * v.y) + (v.z * v.z + v.w * v.w); }
#pragma unroll
    for (int i = 0; i < 2; i++) { const float4 v = ld4(c + 256 + i * 64 + l16 * 4); ss2 += (v.x * v.x + v.y * v.y) + (v.z * v.z + v.w * v.w); }
    ss = row16_sum(ss);
    ss2 = row16_sum(ss2);
    if (l16 == 0) {
      RSQ[t] = rsqrtf(ss * (1.f / 256.f) + NORM_EPS);
      RSKV[t] = rsqrtf(ss2 * (1.f / 128.f) + NORM_EPS);
    }
    {
      const float t1 = bf2f(c[384 + l16]), t2 = bf2f(c[400 + l16]);
      const float ang = (float)p.pos[t] * inv_freq;
      const float cs = cosf(ang), sn = sinf(ang);
      CS[t * 32 + l16] = cs;
      CS[t * 32 + 16 + l16] = sn;
      const u16 o1 = f2bf(t1 * cs - t2 * sn), o2 = f2bf(t2 * cs + t1 * sn);
#pragma unroll
      for (int hh = 0; hh < 8; hh++) {
        const size_t base = ((size_t)(b * 8 + hh) * SEQ + s) * 96 + 64;
        Kb[base + l16] = o1;
        Kb[base + 16 + l16] = o2;
      }
    }
  }
}

DI void kv_epilogue(f32x16 (&acc)[2][2], int m0, int hh, SmemGemm& sm, const float* __restrict__ RSKV, u16* __restrict__ Kb, u16* __restrict__ Vt) {
  const int lane = threadIdx.x & 63, w = threadIdx.x >> 6, wm = w >> 1, wn = w & 1, r = lane & 31, h = lane >> 5;
  float* wb = (float*)&sm + w * (64 * 68);
#pragma unroll
  for (int i = 0; i < 2; i++)
#pragma unroll
    for (int j = 0; j < 2; j++)
#pragma unroll
      for (int g = 0; g < 16; g++)
        wb[(i * 32 + (g & 3) + 8 * (g >> 2) + 4 * h) * 68 + j * 32 + r] = acc[i][j][g];
  __syncthreads();
  const int row0 = m0 + wm * 64, b = row0 >> 12, s0 = row0 & (SEQ - 1);
  if (wn == 0) {
    const int rl = lane >> 4, c4 = (lane & 15) * 4;
#pragma unroll 4
    for (int it = 0; it < 16; it++) {
      const int row_l = it * 4 + rl;
      float4 v = *(const float4*)&wb[row_l * 68 + c4];
      const float rs = RSKV[row0 + row_l];
      v.x *= rs; v.y *= rs; v.z *= rs; v.w *= rs;
      st4(Kb + ((size_t)(b * 8 + hh) * SEQ + s0 + row_l) * 96 + c4, v);
    }
  } else {
    u16* vp = Vt + ((size_t)(b * 8 + hh) * 64 + lane) * LDV + s0;
#pragma unroll 4
    for (int rg = 0; rg < 16; rg++) {
      const float4 rs = *(const float4*)(RSKV + row0 + rg * 4);
      float4 v;
      v.x = wb[(rg * 4 + 0) * 68 + lane] * rs.x; v.y = wb[(rg * 4 + 1) * 68 + lane] * rs.y;
      v.z = wb[(rg * 4 + 2) * 68 + lane] * rs.z; v.w = wb[(rg * 4 + 3) * 68 + lane] * rs.w;
      st4(vp + rg * 4, v);
    }
  }
}

DI void phase3(const Params& p, Smem& sm, int* cnt) {
  char* ws = p.ws;
  const u16* LA = (const u16*)((char*)p.out + D_LA);
  const u16* CQKV = (const u16*)(ws + O_CQKV);
  u16* NLW = (u16*)(ws + O_U);
  u16* Ab = (u16*)(ws + O_U + (size_t)T * 512 * 2);
  u16* Qb = (u16*)(ws + O_Q);
  u16* Kb = (u16*)(ws + O_K);
  u16* Vt = (u16*)((char*)p.out + D_VT);
  const float* RSQ = (const float*)(ws + O_RSQ);
  const float* RSKV = (const float*)(ws + O_RSKV);
  const float* CS = (const float*)(ws + O_CS);
  const float qscale = 1.4426950408889634f * 0.10206207261596575f;
  const int n_dec = 32 * 4, n_icl = 32 * 4, n_q = 32 * 6, n_kv = 32 * 8;
  const int xcd = blockIdx.x & 7, lb = blockIdx.x >> 3, nlb = gridDim.x >> 3;
  for (int li = lb; li < n_dec + n_icl + n_q + n_kv; li += nlb) {
    f32x16 acc[2][2];
    acc_zero(acc);
    if (li < n_dec) {
      const int mt = xcd * 32 + (li >> 2), nt = li & 3;
      gemm_tile_acc(LA, 128, (const u16*)(ws + O_WDEC), 64, 64, mt * 128, nt * 128, acc, sm.g);
      const float* w0 = p.w0;
      const float4 ww = *(const float4*)(w0 + nt * 128 + ((threadIdx.x >> 6) & 1) * 64 + (threadIdx.x & 15) * 4);
      acc_epilogue(acc, mt * 128, nt * 128, sm.g, [&](int row, int col, float4 v) {
        st4(NLW + (size_t)row * 512 + col, make_float4(1.f - __expf(-DECAY_SCALE * sigmoidf_(ww.x + v.x)), 1.f - __expf(-DECAY_SCALE * sigmoidf_(ww.y + v.y)),
                                                       1.f - __expf(-DECAY_SCALE * sigmoidf_(ww.z + v.z)), 1.f - __expf(-DECAY_SCALE * sigmoidf_(ww.w + v.w))));
      });
    } else if (li < n_dec + n_icl) {
      const int tt = li - n_dec, mt = xcd * 32 + (tt >> 2), nt = tt & 3;
      gemm_tile_acc(LA + 64, 128, (const u16*)(ws + O_WICL), 64, 64, mt * 128, nt * 128, acc, sm.g);
      const float* a0 = p.a0;
      const float4 aa = *(const float4*)(a0 + nt * 128 + ((threadIdx.x >> 6) & 1) * 64 + (threadIdx.x & 15) * 4);
      acc_epilogue(acc, mt * 128, nt * 128, sm.g, [&](int row, int col, float4 v) {
        st4(Ab + (size_t)row * 512 + col, sigm4(make_float4(aa.x + v.x, aa.y + v.y, aa.z + v.z, aa.w + v.w)));
      });
    } else if (li < n_dec + n_icl + n_q) {
      const int tt = li - n_dec - n_icl, ml = tt / 6, nt = tt - ml * 6, mt = xcd * 32 + ml;
      gemm_tile_acc(CQKV, CQW, (const u16*)(ws + O_WUQ), LDQW, 256, mt * 128, nt * 128, acc, sm.g);
      struct QOp { float rs; float4 cs, sn; };
      acc_stage(acc, sm.g);
      acc_drain_grp(mt * 128, nt * 128, sm.g,
        [&](int row, int col) {
          const int hh = col / 96, d = col - hh * 96, i = (d - 64) & 15;
          QOp o; o.rs = RSQ[row];
          o.cs = *(const float4*)(CS + (size_t)row * 32 + i);
          o.sn = *(const float4*)(CS + (size_t)row * 32 + 16 + i);
          return o;
        },
        [&](int row, int col, float4 v, QOp o) {
          const int hh = col / 96, d = col - hh * 96, b = row >> 12, s = row & (SEQ - 1);
          const float rs = o.rs * qscale;
          v.x *= rs; v.y *= rs; v.z *= rs; v.w *= rs;
          float4 pv;
          {
            const bool up = (d < 80);
            const float ax = dpp_mov<0x104>(v.x), bx = dpp_mov<0x114>(v.x);
            const float ay = dpp_mov<0x104>(v.y), by = dpp_mov<0x114>(v.y);
            const float az = dpp_mov<0x104>(v.z), bz = dpp_mov<0x114>(v.z);
            const float aw = dpp_mov<0x104>(v.w), bw = dpp_mov<0x114>(v.w);
            pv.x = up ? ax : bx; pv.y = up ? ay : by; pv.z = up ? az : bz; pv.w = up ? aw : bw;
          }
          if (d >= 64) {
            const float sg = (d < 80) ? -1.f : 1.f;
            v.x = v.x * o.cs.x + sg * pv.x * o.sn.x; v.y = v.y * o.cs.y + sg * pv.y * o.sn.y;
            v.z = v.z * o.cs.z + sg * pv.z * o.sn.z; v.w = v.w * o.cs.w + sg * pv.w * o.sn.w;
          }
          st4(Qb + ((size_t)(b * 8 + hh) * SEQ + s) * 96 + d, v);
        });
    } else {
      const int tt = li - n_dec - n_icl - n_q, mt = xcd * 32 + (tt >> 3), nt = tt & 7;
      gemm_tile_acc(CQKV + 256, CQW, (const u16*)(ws + O_WUKV), 128, 128, mt * 128, nt * 128, acc, sm.g);
      kv_epilogue(acc, mt * 128, nt, sm.g, RSKV, Kb, Vt);
    }
  }
}

DI void scan_item(const Params& p, int item, SmemScan& sm) {
  const int tid = threadIdx.x, lane = tid & 63, w = tid >> 6;
  const int vg = item & 3, bh = item >> 2, hh = bh & 7, b = bh >> 3;
  char* ws = p.ws;
  const u16* FA = (const u16*)(ws + O_FA);
  const u16* NLW = (const u16*)(ws + O_U);
  const u16* Ab = (const u16*)(ws + O_U + (size_t)T * 512 * 2);
  float* BONUS = (float*)(ws + O_BONUS);
  u16* Y = (u16*)((char*)p.out + D_YA);
  const int st = tid >> 4, kq = tid & 15, col = hh * 64 + kq * 4;
  float mu_r[4], mu_k[4], mu_v[4], ckk[4], cka[4], crk[4], omc[4];
#pragma unroll
  for (int i = 0; i < 4; i++) {
    mu_r[i] = p.mu[col + i]; mu_k[i] = p.mu[512 + col + i]; mu_v[i] = p.mu[1024 + col + i];
    ckk[i] = p.k_k[col + i]; cka[i] = p.k_a[col + i]; crk[i] = p.r_k[col + i]; omc[i] = 1.f - cka[i];
  }
  struct SIn { uint2 rf, rp, kf, kp, vf, vp, a, w; };
  auto issue = [&](int tc, SIn& g) {
    const int s = tc + st;
    const size_t t = (size_t)b * SEQ + s;
    const u16* fa = FA + t * FAW + col;
    const u16* fp = (s > 0) ? fa - FAW : fa;
    g.rf = *(const uint2*)(fa);
    g.kf = *(const uint2*)(fa + 512);
    g.vf = *(const uint2*)(fa + 1024);
    g.rp = *(const uint2*)(fp);
    g.kp = *(const uint2*)(fp + 512);
    g.vp = *(const uint2*)(fp + 1024);
    g.a = *(const uint2*)(Ab + t * 512 + col);
    g.w = *(const uint2*)(NLW + t * 512 + col);
  };
  auto unp = [](uint2 u, float (&f)[4]) {
    f[0] = __uint_as_float(u.x << 16); f[1] = __uint_as_float(u.x & 0xffff0000u);
    f[2] = __uint_as_float(u.y << 16); f[3] = __uint_as_float(u.y & 0xffff0000u);
  };
  auto process = [&](int tc, const SIn& g, int pb) {
    float rf[4], rp[4], kf[4], kp[4], vf[4], vp[4], av[4], nl[4];
    unp(g.rf, rf); unp(g.rp, rp); unp(g.kf, kf); unp(g.kp, kp); unp(g.vf, vf); unp(g.vp, vp); unp(g.a, av); unp(g.w, nl);
    if (tc + st == 0) {
#pragma unroll
      for (int i = 0; i < 4; i++) { rp[i] = 0.f; kp[i] = 0.f; vp[i] = 0.f; }
    }
    float rr[4], ks[4], vs[4], kkr[4];
    float n2 = 0.f, bon = 0.f;
#pragma unroll
    for (int i = 0; i < 4; i++) {
      rr[i] = rf[i] + mu_r[i] * (rp[i] - rf[i]);
      ks[i] = kf[i] + mu_k[i] * (kp[i] - kf[i]);
      vs[i] = vf[i] + mu_v[i] * (vp[i] - vf[i]);
      kkr[i] = ks[i] * ckk[i];
      n2 += kkr[i] * kkr[i];
    }
    n2 = row16_sum(n2);
    const float inv = __builtin_amdgcn_rsqf(fmaxf(n2, 1e-24f));
    float4 o_w, o_kk, o_b, o_kx, o_r;
    float kx[4], kk[4];
#pragma unroll
    for (int i = 0; i < 4; i++) {
      kk[i] = kkr[i] * inv;
      kx[i] = ks[i] * (av[i] * cka[i] + omc[i]);
      bon += rr[i] * kx[i] * crk[i];
    }
    bon = row16_sum(bon);
    o_w = make_float4(1.f - nl[0], 1.f - nl[1], 1.f - nl[2], 1.f - nl[3]);
    o_kk = make_float4(kk[0], kk[1], kk[2], kk[3]);
    o_b = make_float4(kk[0] * av[0], kk[1] * av[1], kk[2] * av[2], kk[3] * av[3]);
    o_kx = make_float4(kx[0], kx[1], kx[2], kx[3]);
    o_r = make_float4(rr[0], rr[1], rr[2], rr[3]);
    *(float4*)&sm.vec[pb][st][0][kq * 4] = o_w;
    *(float4*)&sm.vec[pb][st][1][kq * 4] = o_kk;
    *(float4*)&sm.vec[pb][st][2][kq * 4] = o_b;
    *(float4*)&sm.vec[pb][st][3][kq * 4] = o_kx;
    *(float4*)&sm.vec[pb][st][4][kq * 4] = o_r;
    if ((kq >> 2) == vg) *(float4*)&sm.v[pb][st][(kq & 3) * 4] = make_float4(vs[0], vs[1], vs[2], vs[3]);
    if (vg == 0 && kq == 0) BONUS[((size_t)b * SEQ + tc + st) * 8 + hh] = bon;
  };
  const int vl = lane >> 4, kg = lane & 15;
  const int rowb = w * 4 + vl;
  f32x2 S01 = {0.f, 0.f}, S23 = {0.f, 0.f};
  const int ys = lane >> 2, yr = w * 4 + (lane & 3);
  SIn gA, gB;
  issue(0, gA);
  issue(16, gB);
  __syncthreads();
  process(0, gA, 0);
  __syncthreads();
#define LO2(v) (f32x2{(v).x, (v).y})
#define HI2(v) (f32x2{(v).z, (v).w})
#define SCAN_CHUNK(tc_, gfree, gnext, cb) do { \
    process(((tc_) + 16 < SEQ) ? (tc_) + 16 : SEQ - 16, gnext, (cb) ^ 1); \
    issue(((tc_) + 32 < SEQ) ? (tc_) + 32 : SEQ - 16, gfree); \
    float4 w4 = *(const float4*)&sm.vec[cb][0][0][kg * 4]; \
    float4 kk4 = *(const float4*)&sm.vec[cb][0][1][kg * 4]; \
    float4 b4 = *(const float4*)&sm.vec[cb][0][2][kg * 4]; \
    float4 kx4 = *(const float4*)&sm.vec[cb][0][3][kg * 4]; \
    float4 r4 = *(const float4*)&sm.vec[cb][0][4][kg * 4]; \
    float vv = sm.v[cb][0][rowb]; \
    _Pragma("unroll") for (int s = 0; s < 16; s++) { \
      const int sn = (s < 15) ? s + 1 : 15; \
      const float4 nw4 = *(const float4*)&sm.vec[cb][sn][0][kg * 4]; \
      const float4 nkk4 = *(const float4*)&sm.vec[cb][sn][1][kg * 4]; \
      const float4 nb4 = *(const float4*)&sm.vec[cb][sn][2][kg * 4]; \
      const float4 nkx4 = *(const float4*)&sm.vec[cb][sn][3][kg * 4]; \
      const float4 nr4 = *(const float4*)&sm.vec[cb][sn][4][kg * 4]; \
      const float nvv = sm.v[cb][sn][rowb]; \
      const f32x2 d2 = S23 * HI2(kk4) + S01 * LO2(kk4); \
      const f32x2 vv2 = {vv, vv}; \
      const f32x2 t01 = vv2 * LO2(kx4) + S01 * LO2(w4); \
      const f32x2 t23 = vv2 * HI2(kx4) + S23 * HI2(w4); \
      const float d = row16_sum(d2.x + d2.y); \
      const f32x2 dd = {d, d}; \
      S01 = t01 - dd * LO2(b4); \
      S23 = t23 - dd * HI2(b4); \
      const f32x2 y2 = S23 * HI2(r4) + S01 * LO2(r4); \
      sm.yp[s][rowb][kg] = y2.x + y2.y; \
      w4 = nw4; kk4 = nkk4; b4 = nb4; kx4 = nkx4; r4 = nr4; vv = nvv; \
    } \
    {     \
      const float4 p0 = *(const float4*)&sm.yp[ys][yr][0], p1 = *(const float4*)&sm.yp[ys][yr][4]; \
      const float4 p2 = *(const float4*)&sm.yp[ys][yr][8], p3 = *(const float4*)&sm.yp[ys][yr][12]; \
      const float y = ((p0.x + p0.y) + (p0.z + p0.w)) + ((p1.x + p1.y) + (p1.z + p1.w)) + ((p2.x + p2.y) + (p2.z + p2.w)) + ((p3.x + p3.y) + (p3.z + p3.w)); \
      Y[((size_t)b * SEQ + (tc_) + ys) * LDY + hh * 64 + vg * 16 + yr] = f2bf(y); \
    } \
    __syncthreads(); } while (0)
#pragma unroll 1
  for (int tc = 0; tc < SEQ; tc += 32) {
    SCAN_CHUNK(tc, gA, gB, 0);
    SCAN_CHUNK(tc + 16, gB, gA, 1);
  }
  __syncthreads();
}

DI void attn_item(const Params& p, int bh, int qb, SmemAttn& sm) {
  const int tid = threadIdx.x, lane = tid & 63, w = tid >> 6, r = lane & 31, h = lane >> 5;
  char* ws = p.ws;
  const u16* Qb = (const u16*)(ws + O_Q) + (size_t)bh * SEQ * 96;
  const u16* Kb = (const u16*)(ws + O_K) + (size_t)bh * SEQ * 96;
  const u16* Vt = (const u16*)((char*)p.out + D_VT) + (size_t)bh * 64 * LDV;
  const u16* SZB = (const u16*)(ws + O_SZB);
  u16* O = (u16*)((char*)p.out + D_O);
  const int b = bh >> 3, hh = bh & 7;
  const int q0 = qb * 128;
  const int qw = q0 + w * 32;
  const int qg = qw + r;
#if NAIVE_ATTN
  if (h == 0) {
    float m = -1e30f, l = 0.f;
    const size_t t = (size_t)b * SEQ + qg;
    for (int dc = 0; dc < 64; dc += 16) {
      float o[16];
      m = -1e30f; l = 0.f;
#pragma unroll
      for (int d = 0; d < 16; d++) o[d] = 0.f;
      for (int key = 0; key <= qg; key++) {
        float s = 0.f;
        for (int d = 0; d < 96; d++) s += bf2f(Qb[(size_t)qg * 96 + d]) * bf2f(Kb[(size_t)key * 96 + d]);
        float mn = fmaxf(m, s);
        float al = exp2f(m - mn), pp = exp2f(s - mn);
        l = l * al + pp;
#pragma unroll
        for (int d = 0; d < 16; d++) o[d] = o[d] * al + pp * bf2f(Vt[(size_t)(dc + d) * LDV + key]);
        m = mn;
      }
#pragma unroll
      for (int d = 0; d < 16; d++) O[t * LDY + hh * 64 + dc + d] = f2bf(o[d] / l * bf2f(SZB[t * 512 + hh * 64 + dc + d]));
    }
  }
#else
  bf16x8 bq[6];
#pragma unroll
  for (int s = 0; s < 6; s++) bq[s] = *(const bf16x8*)(Qb + (size_t)qg * 96 + s * 16 + h * 8);
  const f32x16 zero16 = {0.f, 0.f, 0.f, 0.f, 0.f, 0.f, 0.f, 0.f, 0.f, 0.f, 0.f, 0.f, 0.f, 0.f, 0.f, 0.f};
  f32x16 oacc[2];
#pragma unroll
  for (int g = 0; g < 16; g++) { oacc[0][g] = 0.f; oacc[1][g] = 0.f; }
  float m_run = -1e30f, l_run = 0.f;
  const int nkt = (q0 + 128) >> 6;
  u32x4 RK0, RK1, RK2, RV0, RV1;
  const int kr0 = tid / 12, kc0 = tid - kr0 * 12;
  const int kr1 = (tid + 256) / 12, kc1 = (tid + 256) - kr1 * 12;
  const int kr2 = (tid + 512) / 12, kc2 = (tid + 512) - kr2 * 12;
  const int vr0 = tid >> 3, vc0 = tid & 7;
#define ATT_KISSUE(kt_) do { const int k0_ = (((kt_) < nkt) ? (kt_) : nkt - 1) << 6; \
    RK0 = *(const u32x4*)(Kb + (size_t)(k0_ + kr0) * 96 + kc0 * 8); \
    RK1 = *(const u32x4*)(Kb + (size_t)(k0_ + kr1) * 96 + kc1 * 8); \
    RK2 = *(const u32x4*)(Kb + (size_t)(k0_ + kr2) * 96 + kc2 * 8); } while (0)
#define ATT_VISSUE(kt_) do { const int k0_ = (((kt_) < nkt) ? (kt_) : nkt - 1) << 6; \
    RV0 = *(const u32x4*)(Vt + (size_t)vr0 * LDV + k0_ + vc0 * 8); \
    RV1 = *(const u32x4*)(Vt + (size_t)(vr0 + 32) * LDV + k0_ + vc0 * 8); } while (0)
#define ATT_KSTASH(buf) do { \
    *(u32x4*)&sm.k[buf][kr0][kc0 * 8] = RK0; *(u32x4*)&sm.k[buf][kr1][kc1 * 8] = RK1; *(u32x4*)&sm.k[buf][kr2][kc2 * 8] = RK2; } while (0)
#define ATT_VSTASH(buf) do { \
    *(u32x4*)&sm.vt[buf][vr0][vc0 * 8] = RV0; *(u32x4*)&sm.vt[buf][vr0 + 32][vc0 * 8] = RV1; } while (0)
#define ATT_S(SD, buf) do { \
      _Pragma("unroll") for (int kb = 0; kb < 2; kb++) { \
        { const bf16x8 kf0 = *(const bf16x8*)&sm.k[buf][kb * 32 + r][h * 8]; \
          SD[kb] = __builtin_amdgcn_mfma_f32_32x32x16_bf16(kf0, bq[0], zero16, 0, 0, 0); } \
        _Pragma("unroll") for (int s = 1; s < 6; s++) { \
          const bf16x8 kf = *(const bf16x8*)&sm.k[buf][kb * 32 + r][s * 16 + h * 8]; \
          SD[kb] = __builtin_amdgcn_mfma_f32_32x32x16_bf16(kf, bq[s], SD[kb], 0, 0, 0); \
        } \
      } } while (0)
#define ATT_SMPV(sacc, kt, buf) do { \
      const int k0 = (kt) << 6; \
      if (k0 + 63 > qw) { \
        _Pragma("unroll") for (int kb = 0; kb < 2; kb++) \
          _Pragma("unroll") for (int g = 0; g < 16; g++) { \
            const int key = k0 + kb * 32 + (g & 3) + 8 * (g >> 2) + 4 * h; \
            if (key > qg) sacc[kb][g] = -1e30f; \
          } \
      } \
      float mloc = -1e30f; \
      _Pragma("unroll") for (int kb = 0; kb < 2; kb++) \
        _Pragma("unroll") for (int g = 0; g < 16; g++) mloc = fmaxf(mloc, sacc[kb][g]); \
      mloc = fmaxf(mloc, __shfl_xor(mloc, 32, 64)); \
      const float m_new = fmaxf(m_run, mloc); \
      if (__any(m_new > m_run)) { \
        const float alpha = __builtin_amdgcn_exp2f(m_run - m_new); \
        l_run *= alpha; \
        _Pragma("unroll") for (int g = 0; g < 16; g++) { oacc[0][g] *= alpha; oacc[1][g] *= alpha; } \
        m_run = m_new; \
      } \
      float psum = 0.f; \
      _Pragma("unroll") for (int kb = 0; kb < 2; kb++) \
        _Pragma("unroll") for (int g = 0; g < 16; g++) { \
          const float pv = __builtin_amdgcn_exp2f(sacc[kb][g] - m_run); \
          sacc[kb][g] = pv; \
          psum += pv; \
        } \
      l_run += psum; \
      _Pragma("unroll") for (int kb = 0; kb < 2; kb++) \
        _Pragma("unroll") for (int sp = 0; sp < 2; sp++) { \
          uint4 pk; \
          pk.x = pack2(sacc[kb][8 * sp + 0], sacc[kb][8 * sp + 1]); \
          pk.y = pack2(sacc[kb][8 * sp + 2], sacc[kb][8 * sp + 3]); \
          pk.z = pack2(sacc[kb][8 * sp + 4], sacc[kb][8 * sp + 5]); \
          pk.w = pack2(sacc[kb][8 * sp + 6], sacc[kb][8 * sp + 7]); \
          const bf16x8 pf = __builtin_bit_cast(bf16x8, pk); \
          _Pragma("unroll") for (int db = 0; db < 2; db++) { \
            const s16x4 lo = *(const s16x4*)&sm.vt[buf][db * 32 + r][kb * 32 + 16 * sp + 4 * h]; \
            const s16x4 hi = *(const s16x4*)&sm.vt[buf][db * 32 + r][kb * 32 + 16 * sp + 8 + 4 * h]; \
            const bf16x8 vf = __builtin_shufflevector(lo, hi, 0, 1, 2, 3, 4, 5, 6, 7); \
            oacc[db] = __builtin_amdgcn_mfma_f32_32x32x16_bf16(vf, pf, oacc[db], 0, 0, 0); \
          } \
        } \
    } while (0)
#define ATT_ITER(kt, SC, SN, par) do { \
    ATT_KSTASH((par) ^ 1); \
    ATT_VSTASH(par); \
    __syncthreads(); \
    ATT_KISSUE((kt) + 2); \
    ATT_VISSUE((kt) + 1); \
    if ((kt) + 1 < nkt && (((kt) + 1) << 6) <= qw + 31) ATT_S(SN, (par) ^ 1); \
    if (((kt) << 6) <= qw + 31) ATT_SMPV(SC, kt, par); \
  } while (0)
  f32x16 SA[2], SB[2];
  ATT_KISSUE(0);
  __syncthreads();
  ATT_KSTASH(0);
  __syncthreads();
  ATT_KISSUE(1);
  ATT_VISSUE(0);
  ATT_S(SA, 0);
#pragma unroll 1
  for (int kt = 0; kt < nkt; kt += 2) {
    ATT_ITER(kt, SA, SB, 0);
    ATT_ITER(kt + 1, SB, SA, 1);
  }
  const float l_tot = l_run + __shfl_xor(l_run, 32, 64);
  const float inv_l = 1.f / l_tot;
  const size_t t = (size_t)b * SEQ + qg;
#pragma unroll
  for (int db = 0; db < 2; db++)
#pragma unroll
    for (int gq = 0; gq < 4; gq++) {
      const int d = db * 32 + 8 * gq + 4 * h;
      const uint2 z = *(const uint2*)(SZB + t * 512 + hh * 64 + d);
      const float z0 = __uint_as_float(z.x << 16), z1 = __uint_as_float(z.x & 0xffff0000u);
      const float z2 = __uint_as_float(z.y << 16), z3 = __uint_as_float(z.y & 0xffff0000u);
      uint2 o;
      o.x = pack2(oacc[db][4 * gq + 0] * inv_l * z0, oacc[db][4 * gq + 1] * inv_l * z1);
      o.y = pack2(oacc[db][4 * gq + 2] * inv_l * z2, oacc[db][4 * gq + 3] * inv_l * z3);
      *(uint2*)(O + t * LDY + hh * 64 + d) = o;
    }
#endif
}

DI void phase4(const Params& p, Smem& sm, int* cnt, int mode = 0) {
  __shared__ int s_v;
  const unsigned xcc = xcc_id();
  if (threadIdx.x == 0) s_v = atomicExch(&cnt[64 + xcc * 256 + cu_key()], 1);
  __syncthreads();
  const bool scan_first = (s_v == 0);
  __syncthreads();
  if (scan_first && mode != 2) {
    if (threadIdx.x == 0) s_v = atomicAdd(&cnt[8], 1);
    __syncthreads();
    const int item = s_v;
    __syncthreads();
    if (item < 256) {
      __builtin_amdgcn_s_setprio(3);
      scan_item(p, item, sm.sc);
      __builtin_amdgcn_s_setprio(0);
    }
  }
  QState qs; qs.q = (int)xcc; qs.tried = 0;
  if (mode != 1) for (;;) {
    const int li = fetch_item(cnt, 256, qs);
    if (li < 0) break;
    attn_item(p, qs.q * 8 + (li >> 5), 31 - (li & 31), sm.at);
  }
  if (mode != 2) for (;;) {
    __syncthreads();
    if (threadIdx.x == 0) s_v = atomicAdd(&cnt[8], 1);
    __syncthreads();
    const int item = s_v;
    if (item >= 256) break;
    scan_item(p, item, sm.sc);
  }
}

DI void phase5(const Params& p) {
  const long gtid = (long)blockIdx.x * 256 + threadIdx.x, nth = (long)gridDim.x * 256;
  const int lane = threadIdx.x & 63, sub = lane >> 4, l16 = lane & 15;
  const long wave = gtid >> 6, nw = nth >> 6;
  char* ws = p.ws;
  const u16* FA = (const u16*)(ws + O_FA);
  const u16* SZA = (const u16*)(ws + O_SZA);
  const float* BONUS = (const float*)(ws + O_BONUS);
  u16* Y = (u16*)((char*)p.out + D_YA);
  for (long it = wave; it < (long)T * 2; it += nw) {
    const long item = it * 4 + sub;
    const long t = item >> 3;
    const int hh = (int)(item & 7), c = hh * 64 + l16 * 4;
    const int s = (int)(t & (SEQ - 1));
    const float4 y = ld4(Y + t * LDY + c);
    const float mean = row16_sum((y.x + y.y) + (y.z + y.w)) * (1.f / 64.f);
    const float d0 = y.x - mean, d1 = y.y - mean, d2 = y.z - mean, d3 = y.w - mean;
    const float var = row16_sum((d0 * d0 + d1 * d1) + (d2 * d2 + d3 * d3)) * (1.f / 64.f);
    const float rstd = rsqrtf(var + GN_EPS);
    const float4 gg = *(const float4*)(p.gn_g + c), gb = *(const float4*)(p.gn_b + c), mu = *(const float4*)(p.mu + 1024 + c);
    const float4 vf = ld4(FA + t * FAW + 1024 + c);
    float4 vp = ld4(FA + (s > 0 ? t - 1 : t) * FAW + 1024 + c);
    if (s == 0) vp = make_float4(0.f, 0.f, 0.f, 0.f);
    const float bon = BONUS[t * 8 + hh];
    const float4 z = ld4(SZA + t * 512 + c);
    float4 o;
    o.x = (d0 * rstd * gg.x + gb.x + bon * (vf.x + mu.x * (vp.x - vf.x))) * z.x;
    o.y = (d1 * rstd * gg.y + gb.y + bon * (vf.y + mu.y * (vp.y - vf.y))) * z.y;
    o.z = (d2 * rstd * gg.z + gb.z + bon * (vf.z + mu.z * (vp.z - vf.z))) * z.z;
    o.w = (d3 * rstd * gg.w + gb.w + bon * (vf.w + mu.w * (vp.w - vf.w))) * z.w;
    st4(Y + t * LDY + c, o);
  }
}

DI void phase6(const Params& p, Smem& sm, int* cnt) {
  char* ws = p.ws;
  const u16* YA = (const u16*)((char*)p.out + D_YA);
  const u16* O = (const u16*)((char*)p.out + D_O);
  const u16* G = (const u16*)(ws + O_G);
  u16* MG = (u16*)(ws + O_U);
  const int xcd = blockIdx.x & 7, lb = blockIdx.x >> 3, nlb = gridDim.x >> 3;
  for (int li = lb; li < 256; li += nlb) {
    const int mt = xcd * 32 + (li >> 3), nt = li & 7;
    f32x16 acc[2][2];
    acc_zero(acc);
    u32 pk1[2][2][8];
    gemm_tile_dual(YA, (const u16*)(ws + O_WOA), O, (const u16*)(ws + O_WOB), LDY, LDY, mt * 128, nt * 128, acc, pk1, sm.g);
    acc_epilogue2(pk1, acc, mt * 128, nt * 128, sm.g,
      [&](int row, int col) {
        const uint2 a = *(const uint2*)(G + (size_t)row * LDG + col), bq = *(const uint2*)(G + (size_t)row * LDG + 1024 + col);
        return make_uint4(a.x, a.y, bq.x, bq.y);
      },
      [&](int row, int col, float4 va, float4 vb, uint4 gp) {
        const float4 ga = make_float4(__uint_as_float(gp.x << 16), __uint_as_float(gp.x & 0xffff0000u), __uint_as_float(gp.y << 16), __uint_as_float(gp.y & 0xffff0000u));
        const float4 gb = make_float4(__uint_as_float(gp.z << 16), __uint_as_float(gp.z & 0xffff0000u), __uint_as_float(gp.w << 16), __uint_as_float(gp.w & 0xffff0000u));
        st4(MG + (size_t)row * LDU + col, make_float4(va.x * ga.x + vb.x * gb.x, va.y * ga.y + vb.y * gb.y,
                                                     va.z * ga.z + vb.z * gb.z, va.w * ga.w + vb.w * gb.w));
      });
  }
}

DI void phase7(const Params& p, Smem& sm, int* cnt) {
  char* ws = p.ws;
  const u16* MG = (const u16*)(ws + O_U);
  u16* TP = (u16*)(ws + O_FA);
  const int xcd = blockIdx.x & 7, lb = blockIdx.x >> 3, nlb = gridDim.x >> 3;
  for (int li = lb; li < 256; li += nlb) {
    const int mt = xcd * 32 + (li >> 3), nt = li & 7;
    f32x16 acc[2][2];
    acc_zero(acc);
    gemm_tile_acc(MG, LDU, (const u16*)(ws + O_WO), LDU, 1024, mt * 128, nt * 128, acc, sm.g);
    acc_epilogue(acc, mt * 128, nt * 128, sm.g, [&](int row, int col, float4 v) { st4(TP + (size_t)row * LDU + col, v); });
  }
}

DI void phase8(const Params& p) {
  int bz;
  asm volatile("v_mov_b32 %0, 0" : "=v"(bz));
  const long gtid = (long)(blockIdx.x + bz) * 256 + threadIdx.x, nth = (long)gridDim.x * 256;
  const int lane = threadIdx.x & 63;
  const long wave = gtid >> 6, nw = nth >> 6;
  const u16* TP = (const u16*)(p.ws + O_FA);
  for (long row = wave; row < T; row += nw) {
    float v[16];
    float ss = 0.f;
#pragma unroll
    for (int i = 0; i < 2; i++) {
      const uint4 u = *(const uint4*)(TP + row * LDU + i * 512 + lane * 8);
      v[i * 8 + 0] = __uint_as_float(u.x << 16); v[i * 8 + 1] = __uint_as_float(u.x & 0xffff0000u);
      v[i * 8 + 2] = __uint_as_float(u.y << 16); v[i * 8 + 3] = __uint_as_float(u.y & 0xffff0000u);
      v[i * 8 + 4] = __uint_as_float(u.z << 16); v[i * 8 + 5] = __uint_as_float(u.z & 0xffff0000u);
      v[i * 8 + 6] = __uint_as_float(u.w << 16); v[i * 8 + 7] = __uint_as_float(u.w & 0xffff0000u);
    }
#pragma unroll
    for (int i = 0; i < 16; i++) ss += v[i] * v[i];
    ss = wave_sum(ss);
    const float rs = rsqrtf(ss * (1.f / 1024.f) + NORM_EPS);
#pragma unroll
    for (int i = 0; i < 4; i++) {
      const int c = (i >> 1) * 512 + lane * 8 + (i & 1) * 4;
      const float4 g = *(const float4*)(p.g_post + c);
      const float4 xx = *(const float4*)(p.x + row * 1024 + c);
      float4 o;
      o.x = xx.x + v[i * 4 + 0] * rs * g.x; o.y = xx.y + v[i * 4 + 1] * rs * g.y;
      o.z = xx.z + v[i * 4 + 2] * rs * g.z; o.w = xx.w + v[i * 4 + 3] * rs * g.w;
      *(float4*)(p.out + row * 1024 + c) = o;
    }
  }
}

__global__ void __launch_bounds__(256, 2) fwd_megakernel(Params p) {
  cg::grid_group grid = cg::this_grid();
  __shared__ Smem sm;
  int* cnt = (int*)(p.ws + O_CNT);
  GBar gb;
  gbar_init(gb, (unsigned*)(p.ws + O_CNT) + 12288);
  if (p.never) grid.sync();
#define GSYNC() gbar_sync(gb)
  phase0(p);
  GSYNC();
  if (PROBE == 0) { phase0(p); GSYNC(); }
  phase1(p, sm, cnt);
  GSYNC();
  if (PROBE == 1) { phase1(p, sm, cnt + 4096); GSYNC(); }
  phase2(p);
  GSYNC();
  if (PROBE == 2) { phase2(p); GSYNC(); }
  phase3(p, sm, cnt + 8);
  GSYNC();
  if (PROBE == 3) { phase3(p, sm, cnt + 4096); GSYNC(); }
  if (PROBE == 41) { phase4(p, sm, cnt + 4096, 1); GSYNC(); }
  if (PROBE == 42) { phase4(p, sm, cnt + 4096, 2); GSYNC(); }
  phase4(p, sm, cnt + 1024);
  GSYNC();
  if (PROBE == 4) { phase4(p, sm, cnt + 4096); GSYNC(); }
  phase5(p);
  GSYNC();
  phase6(p, sm, cnt + 16);
  GSYNC();
  if (PROBE == 6) { phase6(p, sm, cnt + 4096); GSYNC(); }
  phase7(p, sm, cnt + 24);
  GSYNC();
  if (PROBE == 7) { phase7(p, sm, cnt + 4096); GSYNC(); }
  if (PROBE == 80) { for (int rep = 0; rep < 8; rep++) GSYNC(); }
  phase8(p);
}

extern "C" void kernel_launch(void* const* d_in, const int* in_sizes, int n_in,
                              void* d_out, int out_size, void* d_ws, size_t ws_size,
                              hipStream_t stream) {
  static int grid_blocks = 0;
  if (!grid_blocks) {
    int dev = 0, cus = 0, per_cu = 0;
    hipGetDevice(&dev);
    hipDeviceGetAttribute(&cus, hipDeviceAttributeMultiprocessorCount, dev);
    hipOccupancyMaxActiveBlocksPerMultiprocessor(&per_cu, fwd_megakernel, 256, 0);
    if (per_cu > 2) per_cu = 2;
    if (per_cu < 1) per_cu = 1;
    grid_blocks = cus * per_cu;
  }
  if (ws_size < WS_NEED) { fprintf(stderr, "workspace too small: %zu < %zu\n", ws_size, (size_t)WS_NEED); return; }
  Params p{};
  p.x = (const float*)d_in[0]; p.pos = (const int*)d_in[1]; p.g_pre = (const float*)d_in[2]; p.w_in = (const float*)d_in[3];
  p.b_gate = (const float*)d_in[4]; p.mu = (const float*)d_in[5]; p.w0 = (const float*)d_in[6]; p.w_dec = (const float*)d_in[7];
  p.a0 = (const float*)d_in[8]; p.w_icl = (const float*)d_in[9]; p.k_k = (const float*)d_in[10]; p.k_a = (const float*)d_in[11];
  p.r_k = (const float*)d_in[12]; p.gn_g = (const float*)d_in[13]; p.gn_b = (const float*)d_in[14]; p.w_oa = (const float*)d_in[15];
  p.g_q = (const float*)d_in[16]; p.w_uq = (const float*)d_in[17]; p.g_kv = (const float*)d_in[18]; p.w_ukv = (const float*)d_in[19];
  p.w_ob = (const float*)d_in[20]; p.w_o = (const float*)d_in[21]; p.g_post = (const float*)d_in[22];
  p.out = (float*)d_out; p.ws = (char*)d_ws;
  p.never = 0;
  (void)hipMemsetAsync((char*)d_ws + O_CNT, 0, 65536, stream);
  void* args[] = {&p};
  hipError_t e = hipLaunchCooperativeKernel((void*)fwd_megakernel, dim3(grid_blocks), dim3(256), args, 0, stream);
  if (e != hipSuccess) fprintf(stderr, "cooperative launch failed: %s (grid %d)\n", hipGetErrorString(e), grid_blocks);
}
```
